# Optimizing an MI355X kernel written in HIP

```python
import math
import jax, jax.numpy as jnp
from jax import lax
import numpy as np

D_MODEL = 1024
BATCH = 16
SEQ = 2048
DEPTH = 2

N_A = max(1, DEPTH // 2)
N_B = DEPTH - N_A
N_HEADS = 16
HEAD_DIM = D_MODEL // N_HEADS
D_FF = 2816
CONV_WIDTH = 3
Q_BLOCK = 128
RMS_EPS = 1e-6

kernel_name = "yoco_shortconv_fox_macaron_sandwich"


def rms_norm(x, g):
    xf = x.astype(jnp.float32)
    y = xf * lax.rsqrt(jnp.mean(xf * xf, axis=-1, keepdims=True) + RMS_EPS)
    return (y * g.astype(jnp.float32)).astype(x.dtype)


def swiglu(x, w_in, w_out):
    gate, up = jnp.split(x @ w_in, 2, axis=-1)
    return (jax.nn.silu(gate) * up) @ w_out


def short_conv_mixer(x, w_in, conv_k, w_out):
    b_gate, c_gate, h = jnp.split(x @ w_in, 3, axis=-1)
    u = c_gate * h
    y = lax.conv_general_dilated(
        u, conv_k[:, None, :].astype(u.dtype),
        window_strides=(1,), padding=[(CONV_WIDTH - 1, 0)],
        dimension_numbers=("NWC", "WIO", "NWC"),
        feature_group_count=D_MODEL)
    return (b_gate * y) @ w_out


def shared_kv(x, kv_g, kv_w, forget_b):
    bsz, seq, _ = x.shape
    p = rms_norm(x, kv_g) @ kv_w
    k = p[..., :D_MODEL].reshape(bsz, seq, N_HEADS, HEAD_DIM).transpose(0, 2, 1, 3)
    v = p[..., D_MODEL:2 * D_MODEL].reshape(bsz, seq, N_HEADS, HEAD_DIM).transpose(0, 2, 1, 3)
    f_logit = (p[..., 2 * D_MODEL:] + forget_b).astype(jnp.float32)
    log_f = jax.nn.log_sigmoid(f_logit)
    c = jnp.cumsum(log_f, axis=1).transpose(0, 2, 1)
    return k, v, c


def forgetting_attention(x, k, v, c, w_qg, w_o):
    bsz, seq, _ = x.shape
    n_blk = seq // Q_BLOCK
    q, gate = jnp.split(x @ w_qg, 2, axis=-1)
    q = q.reshape(bsz, seq, N_HEADS, HEAD_DIM).transpose(0, 2, 1, 3)
    q_blocks = q.reshape(bsz, N_HEADS, n_blk, Q_BLOCK, HEAD_DIM).transpose(2, 0, 1, 3, 4)
    c_blocks = c.reshape(bsz, N_HEADS, n_blk, Q_BLOCK).transpose(2, 0, 1, 3)
    k_pos = jnp.arange(seq)
    scale = 1.0 / math.sqrt(HEAD_DIM)

    def attend_block(args):
        qb, cb, i = args
        s = jnp.einsum("bhqd,bhkd->bhqk", qb, k, preferred_element_type=jnp.float32) * scale
        s = s + cb[..., None] - c[:, :, None, :]
        q_pos = i * Q_BLOCK + jnp.arange(Q_BLOCK)
        s = jnp.where(k_pos[None, :] <= q_pos[:, None], s, -jnp.inf)
        p = jax.nn.softmax(s, axis=-1)
        return jnp.einsum("bhqk,bhkd->bhqd", p.astype(v.dtype), v)

    o = lax.map(attend_block, (q_blocks, c_blocks, jnp.arange(n_blk)))
    o = o.transpose(1, 0, 3, 2, 4).reshape(bsz, seq, D_MODEL)
    return (jax.nn.sigmoid(gate) * o) @ w_o


def setup_inputs(seed: int = 0) -> dict:
    key = jax.random.key(seed)
    ks = jax.random.split(key, 24)
    f32 = jnp.float32

    def w(k, shape, fan_in):
        return jax.random.normal(k, shape, f32) * fan_in ** -0.5

    def gain(k, shape):
        return 1.0 + 0.05 * jax.random.normal(k, shape, f32)

    return {
        "x": jax.random.normal(ks[0], (BATCH, SEQ, D_MODEL), f32),
        "ffn1_pre_g": gain(ks[1], (DEPTH, D_MODEL)),
        "ffn1_post_g": gain(ks[2], (DEPTH, D_MODEL)),
        "ffn1_w_in": w(ks[3], (DEPTH, D_MODEL, 2 * D_FF), D_MODEL),
        "ffn1_w_out": w(ks[4], (DEPTH, D_FF, D_MODEL), D_FF),
        "mix_pre_g": gain(ks[5], (DEPTH, D_MODEL)),
        "mix_post_g": gain(ks[6], (DEPTH, D_MODEL)),
        "ffn2_pre_g": gain(ks[7], (DEPTH, D_MODEL)),
        "ffn2_post_g": gain(ks[8], (DEPTH, D_MODEL)),
        "ffn2_w_in": w(ks[9], (DEPTH, D_MODEL, 2 * D_FF), D_MODEL),
        "ffn2_w_out": w(ks[10], (DEPTH, D_FF, D_MODEL), D_FF),
        "conv_w_in": w(ks[11], (N_A, D_MODEL, 3 * D_MODEL), D_MODEL),
        "conv_k": w(ks[12], (N_A, CONV_WIDTH, D_MODEL), CONV_WIDTH),
        "conv_w_out": w(ks[13], (N_A, D_MODEL, D_MODEL), D_MODEL),
        "kv_g": gain(ks[14], (D_MODEL,)),
        "kv_w": w(ks[15], (D_MODEL, 2 * D_MODEL + N_HEADS), D_MODEL),
        "forget_b": jax.random.uniform(ks[16], (N_HEADS,), f32, 1.0, 3.0),
        "attn_w_qg": w(ks[17], (N_B, D_MODEL, 2 * D_MODEL), D_MODEL),
        "attn_w_o": w(ks[18], (N_B, D_MODEL, D_MODEL), D_MODEL),
    }


def reference(x, ffn1_pre_g, ffn1_post_g, ffn1_w_in, ffn1_w_out, mix_pre_g, mix_post_g,
              ffn2_pre_g, ffn2_post_g, ffn2_w_in, ffn2_w_out, conv_w_in, conv_k, conv_w_out,
              kv_g, kv_w, forget_b, attn_w_qg, attn_w_o):
    k = v = c = None
    for l in range(DEPTH):
        if l == N_A:
            k, v, c = shared_kv(x, kv_g, kv_w, forget_b)
        h = swiglu(rms_norm(x, ffn1_pre_g[l]), ffn1_w_in[l], ffn1_w_out[l])
        x = x + 0.5 * rms_norm(h, ffn1_post_g[l])
        xn = rms_norm(x, mix_pre_g[l])
        if l < N_A:
            m = short_conv_mixer(xn, conv_w_in[l], conv_k[l], conv_w_out[l])
        else:
            j = l - N_A
            m = forgetting_attention(xn, k, v, c, attn_w_qg[j], attn_w_o[j])
        x = x + rms_norm(m, mix_post_g[l])
        h = swiglu(rms_norm(x, ffn2_pre_g[l]), ffn2_w_in[l], ffn2_w_out[l])
        x = x + 0.5 * rms_norm(h, ffn2_post_g[l])
    return x
```

```cpp
#include <hip/hip_runtime.h>
#include <hip/hip_cooperative_groups.h>
#include <cstdio>
#include <cstdint>
namespace cg = cooperative_groups;
namespace pg8 {
#define PG8_LAS __attribute__((address_space(3)))
typedef unsigned short bf16_t;
typedef short bf16x8 __attribute__((ext_vector_type(8)));
typedef float f32x4 __attribute__((ext_vector_type(4)));
typedef unsigned u32x4 __attribute__((ext_vector_type(4)));
constexpr int BM = 256, BK = 64, HALF = 128, HTB = HALF * BK * 2  , STAGE_BYTES = 8 * HTB, NXCD = 8, WGM = 8;

__host__ __device__ __forceinline__ int lds_byte(int r, int c) { const int st = (r >> 4) * 2 + (c >> 5), rr = r & 15, cc = c & 31, ob = rr * 64 + cc * 2; return st * 1024 + (ob ^ (((ob >> 9) & 1) << 5)); }
__host__ __device__ __forceinline__ void stage_rc(int b, int& R, int& C) { const int st = b / 1024, sb = b % 1024, swz = sb ^ (((sb >> 9) & 1) << 5); R = (st >> 1) * 16 + swz / 64; C = (st & 1) * 32 + (swz % 64) / 2; }
__host__ __device__ __forceinline__ int perm32(int rho) { const int n = rho >> 4, i = rho & 15; return 8 * (i >> 2) + 4 * n + (i & 3); }

struct Unit { int pm, pn; };
struct Gemm { const bf16_t* A; const bf16_t* Bt; int M, N, K; };

struct StaticOrder {
    int nM, nN, nwg, G, c;
    __host__ __device__ void init(int M, int N, int G_, int c_) { nM = M / BM; nN = N / BM; nwg = nM * nN; G = G_; c = c_; }
    __host__ __device__ bool next(int i, Unit& u) const {
        const long L = (long)i * G + c; if (L >= nwg) return false;
        int wgid = (int)L; { const int q = nwg / NXCD, r = nwg % NXCD, xcd = wgid % NXCD, off = wgid / NXCD; wgid = (xcd < r ? xcd * (q + 1) : r * (q + 1) + (xcd - r) * q) + off; }
        const int nig = WGM * nN, gid = wgid / nig, fm = gid * WGM, gsz = (nM - fm) < WGM ? (nM - fm) : WGM;
        u.pm = fm + ((wgid % nig) % gsz); u.pn = (wgid % nig) / gsz; return true;
    }
    __device__ __forceinline__ void a_ready(const Unit&) const {}
    __device__ __forceinline__ void done(const Unit&) const {}
};

__device__ __forceinline__ unsigned cvt_pk_bf16(float lo, float hi) { unsigned r; asm volatile("v_cvt_pk_bf16_f32 %0, %1, %2" : "=v"(r) : "v"(lo), "v"(hi)); return r; }
typedef float f32x2 __attribute__((ext_vector_type(2)));
template <class Epi, class Sched, bool ALIGN_EPI = false, bool SP2 = false>
__device__ __forceinline__ void gemm_phase(PG8_LAS unsigned char* lds, const Gemm g, const Sched& S, const Epi& E, const int tid) {
    const int wid = __builtin_amdgcn_readfirstlane(tid >> 6), lane = tid & 63, wr = wid >> 2, wc = wid & 3, fr = lane & 15, fq = lane >> 4;
    const int K = g.K, nt = K / BK;
    unsigned voffA[2], voffB[2];
#pragma unroll
    for (int i = 0; i < 2; ++i) { int R, C; stage_rc(tid * 16 + i * 8192, R, C); const int Rb = Epi::PERM ? ((R & ~31) + perm32(R & 31)) : R;
        voffA[i] = (unsigned)(R * K + C) * 2u; voffB[i] = (unsigned)(Rb * K + C) * 2u; }
    const size_t kstep = (size_t)(BK * 2);
    const size_t hstep = (size_t)HALF * K * 2;
    const size_t tstep = 2 * hstep;
    const unsigned ldsw = (unsigned)wid * 1024u;
    const int aoff = lds_byte(wr * 64 + fr, fq * 8), boff = lds_byte(wc * 32 + fr, fq * 8);
#define PG8_SA(b, h) (((b) * 2 + (h)) * HTB)
#define PG8_SB(b, h) ((4 + (b) * 2 + (h)) * HTB)
#define PG8_STAGE(bufoff, gbase, voff) do { _Pragma("unroll") for (int _i = 0; _i < 2; ++_i) \
        __builtin_amdgcn_global_load_lds((const unsigned*)((const char*)(gbase) + (voff)[_i]), (PG8_LAS unsigned*)(lds + (bufoff) + ldsw + _i * 8192), 16, 0, 0); } while (0)
#define PG8_LDA(dst, b, h) do { _Pragma("unroll") for (int m = 0; m < 4; ++m) _Pragma("unroll") for (int k = 0; k < 2; ++k) dst[m][k] = *(const PG8_LAS bf16x8*)(lds + PG8_SA(b, h) + aoff + m * 2048 + k * 1024); } while (0)
#define PG8_LDB(dst, b, h) do { _Pragma("unroll") for (int n = 0; n < 2; ++n) _Pragma("unroll") for (int k = 0; k < 2; ++k) dst[n][k] = *(const PG8_LAS bf16x8*)(lds + PG8_SB(b, h) + boff + n * 2048 + k * 1024); } while (0)
#define PG8_MMA(ai, bj, At, Bt) do { __builtin_amdgcn_s_setprio(1); _Pragma("unroll") for (int m = 0; m < 4; ++m) _Pragma("unroll") for (int n = 0; n < 2; ++n) _Pragma("unroll") for (int k = 0; k < 2; ++k) \
        acc[ai][bj][m][n] = __builtin_amdgcn_mfma_f32_16x16x32_bf16(Bt[n][k], At[m][k], acc[ai][bj][m][n], 0, 0, 0); __builtin_amdgcn_s_setprio(0); } while (0)
#define PG8_WAIT_V(n) asm volatile("s_waitcnt vmcnt(" #n ")" ::: "memory")
#define PG8_WAIT_L(n) asm volatile("s_waitcnt lgkmcnt(" #n ")" ::: "memory")
#define PG8_BAR __builtin_amdgcn_s_barrier()
#define PG8_SCHED __builtin_amdgcn_sched_barrier(0)
    Unit cur, nxt; int ui = 0;
    if (!S.next(0, cur)) return;
    f32x4 acc[2][2][4][2];
#pragma unroll
    for (int a = 0; a < 2; ++a)
#pragma unroll
        for (int b = 0; b < 2; ++b)
#pragma unroll
            for (int m = 0; m < 4; ++m)
#pragma unroll
                for (int n = 0; n < 2; ++n) acc[a][b][m][n] = (f32x4){0.f, 0.f, 0.f, 0.f};
    bf16x8 At[4][2], B0[2][2], B1[2][2];
    const char* cA = (const char*)g.A + (size_t)cur.pm * tstep; const char* cB = (const char*)g.Bt + (size_t)cur.pn * tstep;
    S.a_ready(cur);
    if constexpr (SP2) {
        PG8_STAGE(PG8_SB(0, 0), cB, voffB); PG8_STAGE(PG8_SB(0, 1), cB + hstep, voffB); PG8_STAGE(PG8_SA(0, 0), cA, voffA); PG8_STAGE(PG8_SA(0, 1), cA + hstep, voffA);
        if (wr == 1) PG8_BAR;
        PG8_WAIT_V(2); PG8_BAR;
        PG8_STAGE(PG8_SB(1, 0), cB + kstep, voffB); PG8_STAGE(PG8_SA(1, 0), cA + kstep, voffA); PG8_STAGE(PG8_SB(1, 1), cB + hstep + kstep, voffB);
        PG8_WAIT_V(6); PG8_BAR;
    } else {
        PG8_STAGE(PG8_SB(0, 0), cB, voffB); PG8_STAGE(PG8_SA(0, 0), cA, voffA); PG8_STAGE(PG8_SB(0, 1), cB + hstep, voffB); PG8_STAGE(PG8_SA(0, 1), cA + hstep, voffA);
        if (wr == 1) PG8_BAR;
        PG8_WAIT_V(4); PG8_BAR;
        PG8_STAGE(PG8_SB(1, 0), cB + kstep, voffB); PG8_STAGE(PG8_SA(1, 0), cA + kstep, voffA); PG8_STAGE(PG8_SB(1, 1), cB + hstep + kstep, voffB);
        PG8_WAIT_V(6); PG8_BAR;
    }
    for (;;) {
        const bool has_next = S.next(ui + 1, nxt);
        const char* nA = has_next ? (const char*)g.A + (size_t)nxt.pm * tstep : cA; const char* nB = has_next ? (const char*)g.Bt + (size_t)nxt.pn * tstep : cB;
        for (int t = 0; t < nt; t += 2) {
            const bool last = (t == nt - 2);
            const char* a1 = cA + (size_t)(t + 1) * kstep;
            const char* a2 = last ? nA : cA + (size_t)(t + 2) * kstep; const char* b2 = last ? nB : cB + (size_t)(t + 2) * kstep;
            const char* a3 = a2 + kstep; const char* b3 = b2 + kstep;
            if (last && has_next) S.a_ready(nxt);
            if constexpr (SP2) {
            PG8_LDB(B0, 0, 0); PG8_LDB(B1, 0, 1); PG8_SCHED; PG8_LDA(At, 0, 0); PG8_STAGE(PG8_SA(1, 1), a1 + hstep, voffA);
            PG8_WAIT_V(8); PG8_WAIT_L(0); PG8_BAR; PG8_MMA(0, 0, At, B0); PG8_MMA(0, 1, At, B1); PG8_BAR; PG8_SCHED;
            PG8_LDA(At, 0, 1); PG8_STAGE(PG8_SB(0, 0), b2, voffB); PG8_STAGE(PG8_SB(0, 1), b2 + hstep, voffB); PG8_STAGE(PG8_SA(0, 0), a2, voffA);
            PG8_WAIT_V(8); PG8_WAIT_L(0); PG8_BAR; PG8_MMA(1, 0, At, B0); PG8_MMA(1, 1, At, B1); PG8_BAR; PG8_SCHED;
            PG8_LDB(B0, 1, 0); PG8_LDB(B1, 1, 1); PG8_SCHED; PG8_LDA(At, 1, 0); PG8_STAGE(PG8_SA(0, 1), a2 + hstep, voffA);
            PG8_WAIT_V(8); PG8_WAIT_L(0); PG8_BAR; PG8_MMA(0, 0, At, B0); PG8_MMA(0, 1, At, B1); PG8_BAR; PG8_SCHED;
            PG8_LDA(At, 1, 1); PG8_STAGE(PG8_SB(1, 0), b3, voffB); PG8_STAGE(PG8_SB(1, 1), b3 + hstep, voffB); PG8_STAGE(PG8_SA(1, 0), a3, voffA);
            PG8_WAIT_V(8); PG8_WAIT_L(0); PG8_BAR; PG8_MMA(1, 0, At, B0); PG8_MMA(1, 1, At, B1); PG8_BAR; PG8_SCHED;
            } else {
            PG8_LDB(B0, 0, 0); PG8_SCHED; PG8_LDA(At, 0, 0); PG8_STAGE(PG8_SA(1, 1), a1 + hstep, voffA);
            PG8_WAIT_L(8); PG8_BAR; PG8_WAIT_L(0); PG8_MMA(0, 0, At, B0); PG8_BAR; PG8_SCHED;
            PG8_LDB(B1, 0, 1); PG8_STAGE(PG8_SB(0, 0), b2, voffB);
            PG8_BAR; PG8_WAIT_L(0); PG8_MMA(0, 1, At, B1); PG8_BAR;
            PG8_LDA(At, 0, 1); PG8_STAGE(PG8_SA(0, 0), a2, voffA);
            PG8_BAR; PG8_WAIT_L(0); PG8_MMA(1, 0, At, B0); PG8_BAR; PG8_SCHED;
            PG8_STAGE(PG8_SB(0, 1), b2 + hstep, voffB);
            PG8_WAIT_V(6); PG8_BAR; PG8_MMA(1, 1, At, B1); PG8_BAR;
            PG8_LDB(B0, 1, 0); PG8_SCHED; PG8_LDA(At, 1, 0); PG8_STAGE(PG8_SA(0, 1), a2 + hstep, voffA);
            PG8_WAIT_L(8); PG8_BAR; PG8_WAIT_L(0); PG8_MMA(0, 0, At, B0); PG8_BAR; PG8_SCHED;
            PG8_LDB(B1, 1, 1); PG8_STAGE(PG8_SB(1, 0), b3, voffB);
            PG8_BAR; PG8_WAIT_L(0); PG8_MMA(0, 1, At, B1); PG8_BAR;
            PG8_LDA(At, 1, 1); PG8_STAGE(PG8_SA(1, 0), a3, voffA);
            PG8_BAR; PG8_WAIT_L(0); PG8_MMA(1, 0, At, B0); PG8_BAR; PG8_SCHED;
            PG8_STAGE(PG8_SB(1, 1), b3 + hstep, voffB);
            PG8_WAIT_V(6); PG8_BAR; PG8_MMA(1, 1, At, B1); PG8_BAR;
            }
        }
        if constexpr (ALIGN_EPI) { if (wr == 0) PG8_BAR; }
        if constexpr (!Epi::AFTER_DRAIN) { E(acc, cur, wr, wc, fr, fq); S.done(cur); }
        if (!has_next) break;
#pragma unroll
        for (int a = 0; a < 2; ++a)
#pragma unroll
            for (int b = 0; b < 2; ++b)
#pragma unroll
                for (int m = 0; m < 4; ++m)
#pragma unroll
                    for (int n = 0; n < 2; ++n) acc[a][b][m][n] = (f32x4){0.f, 0.f, 0.f, 0.f};
        cur = nxt; cA = nA; cB = nB; ++ui;
        if constexpr (ALIGN_EPI) { if (wr == 1) PG8_BAR; }
    }
    PG8_WAIT_V(0);
    if constexpr (!ALIGN_EPI) { if (wr == 0) PG8_BAR; }
    PG8_BAR;
    if constexpr (Epi::AFTER_DRAIN) { E.fused(acc, cur, wr, wc, fr, fq, lds, wid, lane); S.done(cur); }
#undef PG8_SA
#undef PG8_SB
#undef PG8_STAGE
#undef PG8_LDA
#undef PG8_LDB
#undef PG8_MMA
#undef PG8_WAIT_V
#undef PG8_WAIT_L
#undef PG8_BAR
#undef PG8_SCHED
}
}
namespace pg8 {
enum { EM_PLAIN = 0, EM_SWIGLU = 1, EM_CONV = 2, EM_KV = 3, EM_QG = 4 };
struct EpiMulti {
    static constexpr bool PERM = true, AFTER_DRAIN = false;
    typedef __attribute__((address_space(1))) bf16_t* gbf; typedef __attribute__((address_space(1))) float* gf32;
    int mode; gbf O0; gbf O1; gf32 F; int ldc; float qscale;
    __device__ __forceinline__ static void st8(gbf p, f32x4 v0, f32x4 v1) { u32x4 w; w.x = cvt_pk_bf16(v0[0], v0[1]); w.y = cvt_pk_bf16(v0[2], v0[3]); w.z = cvt_pk_bf16(v1[0], v1[1]); w.w = cvt_pk_bf16(v1[2], v1[3]); *(__attribute__((address_space(1))) u32x4*)p = w; }
    __device__ __forceinline__ static f32x4 sigm(f32x4 g) { f32x4 r;
#pragma unroll
        for (int i = 0; i < 4; ++i) r[i] = __builtin_amdgcn_rcpf(1.0f + __builtin_amdgcn_exp2f(g[i] * -1.4426950408889634f)); return r; }
    __device__ __forceinline__ void operator()(const f32x4 (&acc)[2][2][4][2], const Unit& u, int wr, int wc, int fr, int fq) const {
        const int row0 = u.pm * BM + wr * 64 + fr, cl = wc * 32 + 8 * fq;
        if (mode == EM_PLAIN) {
#pragma unroll
            for (int ai = 0; ai < 2; ++ai)
#pragma unroll
                for (int m = 0; m < 4; ++m) { gbf rowp = O0 + (size_t)(row0 + ai * HALF + m * 16) * ldc + u.pn * BM + cl;
#pragma unroll
                    for (int bj = 0; bj < 2; ++bj) st8(rowp + bj * HALF, acc[ai][bj][m][0], acc[ai][bj][m][1]); }
        } else if (mode == EM_SWIGLU) {
#pragma unroll
            for (int ai = 0; ai < 2; ++ai)
#pragma unroll
                for (int m = 0; m < 4; ++m) { gbf rowp = O0 + (size_t)(row0 + ai * HALF + m * 16) * ldc + u.pn * HALF + cl;
                    const f32x4 g0 = acc[ai][0][m][0], g1 = acc[ai][0][m][1];
                    st8(rowp, g0 * sigm(g0) * acc[ai][1][m][0], g1 * sigm(g1) * acc[ai][1][m][1]); }
        } else if (mode == EM_CONV) {
            if (u.pn < 8) {
#pragma unroll
                for (int ai = 0; ai < 2; ++ai)
#pragma unroll
                    for (int m = 0; m < 4; ++m) { gbf rowp = O0 + (size_t)(row0 + ai * HALF + m * 16) * ldc + u.pn * HALF + cl;
                        st8(rowp, acc[ai][0][m][0] * acc[ai][1][m][0], acc[ai][0][m][1] * acc[ai][1][m][1]); }
            } else {
#pragma unroll
                for (int ai = 0; ai < 2; ++ai)
#pragma unroll
                    for (int m = 0; m < 4; ++m) { gbf rowp = O1 + (size_t)(row0 + ai * HALF + m * 16) * ldc + (u.pn - 8) * BM + cl;
#pragma unroll
                        for (int bj = 0; bj < 2; ++bj) st8(rowp + bj * HALF, acc[ai][bj][m][0], acc[ai][bj][m][1]); }
            }
        } else if (mode == EM_KV) {
            if (u.pn < 8) { gbf base = (u.pn < 4) ? O0 : O1; const int ct = (u.pn & 3) * BM + cl;
#pragma unroll
                for (int ai = 0; ai < 2; ++ai)
#pragma unroll
                    for (int m = 0; m < 4; ++m) { gbf rowp = base + (size_t)(row0 + ai * HALF + m * 16) * ldc + ct;
#pragma unroll
                        for (int bj = 0; bj < 2; ++bj) st8(rowp + bj * HALF, acc[ai][bj][m][0], acc[ai][bj][m][1]); }
            } else if (wc == 0 && fq < 2) {
#pragma unroll
                for (int ai = 0; ai < 2; ++ai)
#pragma unroll
                    for (int m = 0; m < 4; ++m) { gf32 fp = F + (size_t)(row0 + ai * HALF + m * 16) * 16 + 8 * fq;
                        *(__attribute__((address_space(1))) f32x4*)fp = acc[ai][0][m][0]; *(__attribute__((address_space(1))) f32x4*)(fp + 4) = acc[ai][0][m][1]; }
            }
        } else {
            const bool isq = u.pn < 4; gbf base = isq ? O0 : O1; const int ct = (u.pn & 3) * BM + cl;
#pragma unroll
            for (int ai = 0; ai < 2; ++ai)
#pragma unroll
                for (int m = 0; m < 4; ++m) { gbf rowp = base + (size_t)(row0 + ai * HALF + m * 16) * ldc + ct;
#pragma unroll
                    for (int bj = 0; bj < 2; ++bj) { f32x4 v0 = acc[ai][bj][m][0], v1 = acc[ai][bj][m][1];
                        if (isq) { v0 = v0 * qscale; v1 = v1 * qscale; } else { v0 = sigm(v0); v1 = sigm(v1); }
                        st8(rowp + bj * HALF, v0, v1); } }
        }
    }
};
}
#ifndef PG8_SP2
#define PG8_SP2 true
#endif
#include <hip/hip_bf16.h>
#include <cmath>
namespace attn_body {
using bf16=__hip_bfloat16;
using bf16x8=__attribute__((ext_vector_type(8)))short;
using s16x4=__attribute__((ext_vector_type(4)))short;
using f32x16=__attribute__((ext_vector_type(16)))float;
using u32x4=__attribute__((ext_vector_type(4)))unsigned;
using f32x4_t=__attribute__((ext_vector_type(4)))float;
constexpr int BATCH=16,NHEAD=16,SEQ=2048,D=64,DM=NHEAD*D;
constexpr int NW=8,QBLK=32,QB=QBLK*NW,KVBLK=64,NQB=SEQ/QB;
constexpr int ATTN_PITCH=DM, ATTN_UNIT_ROWS=QB;
__device__ __forceinline__ int crow(int r,int hi){return (r&3)+8*(r>>2)+4*hi;}
#define SBAR() __builtin_amdgcn_sched_barrier(0)
__device__ __forceinline__ void cmask(f32x16&p0,f32x16&p1,int jb,int qrel,int hi){
  const float NEG=-INFINITY; int kb=64*jb+4*hi;
  #pragma unroll
  for(int r=0;r<16;++r){int kv=kb+(r&3)+8*(r>>2); if(kv>qrel)p0[r]=NEG; if(kv+32>qrel)p1[r]=NEG;}
}

constexpr int NSLOT=3, SLOTB=8192;
constexpr int LDS_K=0, LDS_V=NSLOT*SLOTB, LDS_WS=2*NSLOT*SLOTB, LDS_OST=LDS_WS+NW*64*4, LDS_CT=LDS_OST+NW*4096, LDS_BYTES=LDS_CT+SEQ*4;
constexpr float C2=0.125f*1.4426950408889634f;
__device__ __forceinline__ void glds16(const void*gsrc,unsigned lds_dst){unsigned keep;
  asm volatile("s_mov_b32 %0, m0\n\ts_mov_b32 m0, %2\n\ts_nop 0\n\tglobal_load_lds_dwordx4 %1, off\n\ts_mov_b32 m0, %0":"=&s"(keep):"v"(gsrc),"s"(lds_dst):"memory");}
__device__ __forceinline__ float max3f(float a,float b,float c){float r;asm("v_max3_f32 %0, %1, %2, %3":"=v"(r):"v"(a),"v"(b),"v"(c));return r;}
__device__ __forceinline__ float max2f(float a,float b){float r;asm("v_max_f32_e32 %0, %1, %2":"=v"(r):"v"(a),"v"(b));return r;}
__device__ __forceinline__ float fadd_s(float a,float b){float r;asm("v_add_f32_e32 %0, %1, %2":"=v"(r):"v"(a),"v"(b));return r;}
__device__ __forceinline__ float fsub_s(float a,float b){float r;asm("v_sub_f32_e32 %0, %1, %2":"=v"(r):"v"(a),"v"(b));return r;}
typedef float f32x2_t __attribute__((ext_vector_type(2))); typedef __bf16 bf16x2_t __attribute__((ext_vector_type(2)));
__device__ __forceinline__ unsigned cvtpk_s(float lo,float hi){f32x2_t v={lo,hi};bf16x2_t b=__builtin_convertvector(v,bf16x2_t);return __builtin_bit_cast(unsigned,b);}
#define WAIT_BAR(N) asm volatile("s_waitcnt vmcnt(" #N ") lgkmcnt(0)\n\ts_barrier":::"memory")

__device__ __forceinline__ void qkt(f32x16&p0,f32x16&p1,const char*Kslot,const bf16x8*qr,int r32,int hi){
  const char*kb=Kslot+hi*1024+r32*16;
  #pragma unroll
  for(int d0=0;d0<4;++d0){
    const bf16x8 b0=*reinterpret_cast<const bf16x8*>(kb+d0*2048);
    const bf16x8 b1=*reinterpret_cast<const bf16x8*>(kb+d0*2048+512);
    p0=__builtin_amdgcn_mfma_f32_32x32x16_bf16(b0,qr[d0],p0,0,0,0);p1=__builtin_amdgcn_mfma_f32_32x32x16_bf16(b1,qr[d0],p1,0,0,0);}
}
typedef __attribute__((address_space(3))) const char* lds_cptr;
typedef short v4i16_t __attribute__((ext_vector_type(4)));
__device__ __forceinline__ void kload8(bf16x8*kf,lds_cptr kp){
  kf[0]=*(const __attribute__((address_space(3))) bf16x8*)(kp);      kf[1]=*(const __attribute__((address_space(3))) bf16x8*)(kp+512);
  kf[2]=*(const __attribute__((address_space(3))) bf16x8*)(kp+2048); kf[3]=*(const __attribute__((address_space(3))) bf16x8*)(kp+2560);
  kf[4]=*(const __attribute__((address_space(3))) bf16x8*)(kp+4096); kf[5]=*(const __attribute__((address_space(3))) bf16x8*)(kp+4608);
  kf[6]=*(const __attribute__((address_space(3))) bf16x8*)(kp+6144); kf[7]=*(const __attribute__((address_space(3))) bf16x8*)(kp+6656);
}
__device__ __forceinline__ void kload2(bf16x8*kf,lds_cptr kp,int j){ kf[2*j]=*(const __attribute__((address_space(3))) bf16x8*)(kp+j*2048); kf[2*j+1]=*(const __attribute__((address_space(3))) bf16x8*)(kp+j*2048+512); }
__device__ __forceinline__ s16x4 vtr(lds_cptr p){ return __builtin_bit_cast(s16x4,__builtin_amdgcn_ds_read_tr16_b64_v4i16((__attribute__((address_space(3))) v4i16_t*)p)); }
__device__ __forceinline__ float rowmax(const f32x16&p0,const f32x16&p1){
  float a=max3f(p0[0],p0[1],p1[0]),b=max3f(p0[2],p0[3],p1[1]);a=max3f(a,p1[2],p1[3]);
  #pragma unroll
  for(int r=4;r<16;r+=4){a=max3f(a,p0[r],p0[r+1]);b=max3f(b,p0[r+2],p0[r+3]);a=max3f(a,p1[r],p1[r+1]);b=max3f(b,p1[r+2],p1[r+3]);}
  const float m=max2f(a,b);
  auto rr=__builtin_amdgcn_permlane32_swap(__float_as_uint(m),__float_as_uint(m),false,false);
  return max2f(__uint_as_float(rr[0]),__uint_as_float(rr[1]));
}
__device__ __forceinline__ void pv(f32x16*o,int vb,bf16x8 pa0,bf16x8 pa1,bf16x8 pa2,bf16x8 pa3){
  #pragma unroll
  for(int d0=0;d0<2;++d0){s16x4 lo[4],hi[4];
    #pragma unroll
    for(int ks=0;ks<4;++ks){
      asm volatile("ds_read_b64_tr_b16 %0,%1 offset:%c2":"=&v"(lo[ks]):"v"(vb),"i"(d0*4096+ks*1024):"memory");
      asm volatile("ds_read_b64_tr_b16 %0,%1 offset:%c2":"=&v"(hi[ks]):"v"(vb),"i"(d0*4096+ks*1024+512):"memory");}
    asm volatile("s_waitcnt lgkmcnt(0)":::"memory");SBAR();
    #define PK(k) (bf16x8){lo[k][0],lo[k][1],lo[k][2],lo[k][3],hi[k][0],hi[k][1],hi[k][2],hi[k][3]}
    o[d0]=__builtin_amdgcn_mfma_f32_32x32x16_bf16(pa0,PK(0),o[d0],0,0,0);
    o[d0]=__builtin_amdgcn_mfma_f32_32x32x16_bf16(pa1,PK(1),o[d0],0,0,0);
    o[d0]=__builtin_amdgcn_mfma_f32_32x32x16_bf16(pa2,PK(2),o[d0],0,0,0);
    o[d0]=__builtin_amdgcn_mfma_f32_32x32x16_bf16(pa3,PK(3),o[d0],0,0,0);
    #undef PK
  }
}

#ifndef ATTN_STORE16
#define ATTN_STORE16(p,v) (*(u32x4*)(p)=(v))
#endif
template<int THRL> __device__ __forceinline__ void attn_unit(int b,int h,int qb,const bf16*Q,const bf16*__restrict__ K,const bf16*__restrict__ V,bf16*O,const bf16*__restrict__ GT,const float*__restrict__ C2T,bool load_ct,char*shm,const int tid){
  const int lane=tid&63,r32=lane&31,hi=lane>>5; const int wid=__builtin_amdgcn_readfirstlane(tid>>6);
  const long rowbase=(long)b*SEQ; const int q0=qb*QB;
  const bf16*Qw=Q+(rowbase+q0+wid*QBLK)*DM+h*D;
  const bf16*Kh=K+rowbase*DM+h*D,*Vh=V+rowbase*DM+h*D;
  const unsigned lds0=(unsigned)(uintptr_t)shm;
  float*wsf=(float*)(shm+LDS_WS)+wid*64;
  typedef __attribute__((address_space(3))) f32x4_t* lds_f4p;
  const float*c2row=C2T+((long)b*NHEAD+h)*SEQ;
  if(load_ct){ const f32x4_t cv=*reinterpret_cast<const f32x4_t*>(c2row+tid*4); asm volatile("s_waitcnt vmcnt(0)":::"memory"); *((lds_f4p)(shm+LDS_CT)+tid)=cv; }
  const float cq=c2row[qb*QB+wid*QBLK+r32];
  const __attribute__((address_space(3))) f32x4_t* ctab=(const __attribute__((address_space(3))) f32x4_t*)(shm+LDS_CT)+hi;
  #define CINIT(P0,P1,t) do{ const __attribute__((address_space(3))) f32x4_t* cp_=ctab+(t)*16; const float nm_=cq-mhat; \
    _Pragma("unroll") for(int j_=0;j_<4;++j_){ const f32x4_t a_=cp_[2*j_], b_=cp_[8+2*j_]; \
      P0[4*j_]=nm_-a_[0];P0[4*j_+1]=nm_-a_[1];P0[4*j_+2]=nm_-a_[2];P0[4*j_+3]=nm_-a_[3]; P1[4*j_]=nm_-b_[0];P1[4*j_+1]=nm_-b_[1];P1[4*j_+2]=nm_-b_[2];P1[4*j_+3]=nm_-b_[3]; } }while(0)
  const bf16*ksrc=Kh+(long)lane*DM+wid*8;
  const bf16*vsrc=Vh+(long)(16*(wid&3)+(lane>>2))*DM+(wid>>2)*32+(lane&3)*8;
  const unsigned kdst=lds0+LDS_K+wid*1024, vdst=lds0+LDS_V+wid*1024;
  #define DMA_K(t,slot) glds16(ksrc+(long)(t)*KVBLK*DM,(unsigned)__builtin_amdgcn_readfirstlane(kdst+(slot)))
  #define DMA_V(t,slot) glds16(vsrc+(long)(t)*KVBLK*DM,(unsigned)__builtin_amdgcn_readfirstlane(vdst+(slot)))
  const int vb0=(int)(lds0+LDS_V)+((lane>>4)&1)*32+(lane&3)*8+(4*hi+((lane&15)>>2))*64;
  const char*Kbase=shm+LDS_K; bf16x8 kf[8];
  const lds_cptr shm3=(lds_cptr)shm; const lds_cptr kp0=shm3+LDS_K+hi*1024+r32*16; const lds_cptr vp0=shm3+LDS_V+((lane>>4)&1)*32+(lane&3)*8+(4*hi+((lane&15)>>2))*64;
  const int NT=(q0+QB)/KVBLK;
  DMA_K(0,0);DMA_V(0,0);DMA_K(1,SLOTB);
  bf16x8 qr[4];
  #pragma unroll
  for(int d0=0;d0<4;++d0)qr[d0]=*reinterpret_cast<const bf16x8*>(&Qw[(long)r32*DM+d0*16+hi*8]);
  float mhat=0.f,l_reg=0.f;f32x16 o[2];o[0]=f32x16{};o[1]=f32x16{};
  const int qrel=wid*QBLK+r32;
  #define CMASK(P0,P1,t) do{int jb_=(t)-(NT-4); if(jb_>=0)cmask(P0,P1,jb_,qrel,hi);}while(0)
  bool resc=false;
  #define START(P0,P1) do{ const float rm=rowmax(P0,P1); resc=false; \
    { const float dl=rm; mhat=fadd_s(mhat,dl); \
      _Pragma("unroll") for(int r=0;r<16;++r){P0[r]=fsub_s(P0[r],dl);P1[r]=fsub_s(P1[r],dl);} \
      } \
    _Pragma("unroll") for(int r=0;r<16;++r)P0[r]=__builtin_amdgcn_exp2f(P0[r]); }while(0)
  #define RESC() do{ if(resc){ asm volatile("s_waitcnt lgkmcnt(0)":::"memory"); \
      _Pragma("unroll") for(int d_=0;d_<2;++d_) _Pragma("unroll") for(int r=0;r<16;++r)o[d_][r]*=wsf[crow(r,hi)]; } }while(0)
  f32x16 pA0,pA1,pB0,pB1;
  int sl_prev=0,sl_cur=0,sl_next=SLOTB;
  #define ROT() do{sl_prev=sl_cur;sl_cur=sl_next;sl_next=(sl_next==(NSLOT-1)*SLOTB)?0:sl_next+SLOTB;}while(0)
  DMA_K(2,2*SLOTB);
  WAIT_BAR(3);
  CINIT(pA0,pA1,0);
  qkt(pA0,pA1,Kbase,qr,r32,hi);asm volatile("s_nop 15\n\ts_nop 7":"+v"(pA0),"+v"(pA1));CMASK(pA0,pA1,0);
  START(pA0,pA1);
  _Pragma("unroll") for(int r=0;r<16;++r)pA1[r]=__builtin_amdgcn_exp2f(pA1[r]);
  WAIT_BAR(0);
  DMA_K(3,0);DMA_V(1,SLOTB);
  ROT();
  kload8(kf,kp0+sl_cur);
  WAIT_BAR(2);
  s16x4 vlo[8],vhi[8]; u32x4 pw0,pw1,pw2,pw3;
  #define PKW(P,B) cvtpk_s(P[B],P[B+1])
  #define PAF(k) __builtin_bit_cast(bf16x8,pw##k)
  #define VFR(i) (bf16x8){vlo[i][0],vlo[i][1],vlo[i][2],vlo[i][3],vhi[i][0],vhi[i][1],vhi[i][2],vhi[i][3]}
  #define PIN(x) asm volatile("":"+v"(x))
  #define MX3(a,b,c) __builtin_fmaxf(__builtin_fmaxf((a),(b)),(c))
  #define GAPA(MF,A0,A1,A2,A3,W0,W1,PW) do{ MF; sacc+=A0; sacc+=A1; sacc+=A2; sacc+=A3; PIN(sacc); W0; W1; PIN(PW); SBAR(); }while(0)
  #define EX(v) __builtin_amdgcn_exp2f(v)
  #define GAPB(MF,X,B) do{ MF; X[B]=EX(X[B]); X[B+1]=EX(X[B+1]); X[B+2]=EX(X[B+2]); X[B+3]=EX(X[B+3]); PIN(X); SBAR(); }while(0)
  #define VRD(i) do{ vlo[i]=vtr(vp_+(((i)>>2)*4096+((i)&3)*1024)); vhi[i]=vtr(vp_+(((i)>>2)*4096+((i)&3)*1024+512)); }while(0)
  #define KRD(G,j) do{ if(G){ kload2(kf,kp0+sl_next,j); SBAR(); } }while(0)
  #define STEP(C0,C1,P0,P1,t,GK,GV,GL) do{ SBAR(); CINIT(C0,C1,t); SBAR(); \
    const lds_cptr vp_=vp0+sl_prev; \
    VRD(0); SBAR(); float sacc=(P0[0]+P0[1]); \
    GAPA(C0=__builtin_amdgcn_mfma_f32_32x32x16_bf16(kf[0],qr[0],C0,0,0,0), P0[2],P0[3],P0[4],P0[5],     pw0[0]=PKW(P0,0), pw0[1]=PKW(P0,2), pw0); \
    VRD(4); SBAR(); GAPA(C1=__builtin_amdgcn_mfma_f32_32x32x16_bf16(kf[1],qr[0],C1,0,0,0), P0[6],P0[7],P0[8],P0[9],     pw0[2]=PKW(P0,4), pw0[3]=PKW(P0,6), pw0); \
    VRD(1); SBAR(); GAPA(C0=__builtin_amdgcn_mfma_f32_32x32x16_bf16(kf[2],qr[1],C0,0,0,0),   P0[10],P0[11],P0[12],P0[13], pw1[0]=PKW(P0,8), pw1[1]=PKW(P0,10), pw1); \
    VRD(5); SBAR(); GAPA(C1=__builtin_amdgcn_mfma_f32_32x32x16_bf16(kf[3],qr[1],C1,0,0,0),   P0[14],P0[15],P1[0],P1[1],   pw1[2]=PKW(P0,12),pw1[3]=PKW(P0,14), pw1); \
    VRD(2); SBAR(); GAPA(C0=__builtin_amdgcn_mfma_f32_32x32x16_bf16(kf[4],qr[2],C0,0,0,0),   P1[2],P1[3],P1[4],P1[5],     pw2[0]=PKW(P1,0), pw2[1]=PKW(P1,2), pw2); \
    VRD(6); SBAR(); GAPA(C1=__builtin_amdgcn_mfma_f32_32x32x16_bf16(kf[5],qr[2],C1,0,0,0),   P1[6],P1[7],P1[8],P1[9],     pw2[2]=PKW(P1,4), pw2[3]=PKW(P1,6), pw2); \
    VRD(3); SBAR(); GAPA(C0=__builtin_amdgcn_mfma_f32_32x32x16_bf16(kf[6],qr[3],C0,0,0,0),   P1[10],P1[11],P1[12],P1[13], pw3[0]=PKW(P1,8), pw3[1]=PKW(P1,10), pw3); \
    VRD(7); SBAR(); GAPA(C1=__builtin_amdgcn_mfma_f32_32x32x16_bf16(kf[7],qr[3],C1,0,0,0),   P1[14],P1[15],0.f,0.f,       pw3[2]=PKW(P1,12),pw3[3]=PKW(P1,14), pw3); \
    l_reg+=sacc; \
    if(GK){DMA_K((t)+3,sl_cur);} if(GV){DMA_V((t)+1,sl_next);} \
    CMASK(C0,C1,t); \
    { float a=MX3(C0[0],C0[1],C1[0]),b=MX3(C0[2],C0[3],C1[1]); a=MX3(a,C1[2],C1[3]); \
      _Pragma("unroll") for(int r=4;r<16;r+=4){a=MX3(a,C0[r],C0[r+1]);b=MX3(b,C0[r+2],C0[r+3]);a=MX3(a,C1[r],C1[r+1]);b=MX3(b,C1[r+2],C1[r+3]);} \
      float rm=__builtin_fmaxf(a,b); { auto rr=__builtin_amdgcn_permlane32_swap(__float_as_uint(rm),__float_as_uint(rm),false,false); rm=__builtin_fmaxf(__uint_as_float(rr[0]),__uint_as_float(rr[1])); } \
      resc=false; \
      if(__builtin_expect(__any(rm>(float)THRL),0)){ const float dl=__builtin_fmaxf(rm,0.f); mhat+=dl; \
        _Pragma("unroll") for(int r=0;r<16;++r){C0[r]-=dl;C1[r]-=dl;} \
        const float f=__builtin_amdgcn_exp2f(-dl); l_reg*=f; if(hi==0)wsf[r32]=f; resc=true; } } \
    SBAR(); \
    GAPB(o[0]=__builtin_amdgcn_mfma_f32_32x32x16_bf16(PAF(0),VFR(0),o[0],0,0,0), C0,0); \
    GAPB(o[1]=__builtin_amdgcn_mfma_f32_32x32x16_bf16(PAF(0),VFR(4),o[1],0,0,0), C0,4); \
    KRD(GL,0); GAPB(o[0]=__builtin_amdgcn_mfma_f32_32x32x16_bf16(PAF(1),VFR(1),o[0],0,0,0), C0,8); \
    KRD(GL,1); GAPB(o[1]=__builtin_amdgcn_mfma_f32_32x32x16_bf16(PAF(1),VFR(5),o[1],0,0,0), C0,12); \
    KRD(GL,2); GAPB(o[0]=__builtin_amdgcn_mfma_f32_32x32x16_bf16(PAF(2),VFR(2),o[0],0,0,0), C1,0); \
    KRD(GL,3); GAPB(o[1]=__builtin_amdgcn_mfma_f32_32x32x16_bf16(PAF(2),VFR(6),o[1],0,0,0), C1,4); \
    GAPB(o[0]=__builtin_amdgcn_mfma_f32_32x32x16_bf16(PAF(3),VFR(3),o[0],0,0,0), C1,8); \
    GAPB(o[1]=__builtin_amdgcn_mfma_f32_32x32x16_bf16(PAF(3),VFR(7),o[1],0,0,0), C1,12); \
    }while(0)
  int t=1;
  #undef CMASK
  #define CMASK(P0,P1,t) do{}while(0)
  for(;t+5<NT;t+=2){
    STEP(pB0,pB1,pA0,pA1,t,true,true,true);     WAIT_BAR(2); RESC(); ROT();
    STEP(pA0,pA1,pB0,pB1,t+1,true,true,true);   WAIT_BAR(2); RESC(); ROT();
  }
  #undef CMASK
  #define CMASK(P0,P1,t) do{int jb_=(t)-(NT-4); if(jb_>=0)cmask(P0,P1,jb_,qrel,hi);}while(0)
  #define ENDW(tt) do{ if((tt)+3<NT){WAIT_BAR(2);} else if((tt)+2<NT){WAIT_BAR(1);} else {WAIT_BAR(0);} }while(0)
  for(;t+1<NT;t+=2){
    STEP(pB0,pB1,pA0,pA1,t,(t+3<NT),(t+1<NT),(t+1<NT));       ENDW(t);   RESC(); ROT();
    STEP(pA0,pA1,pB0,pB1,t+1,(t+4<NT),(t+2<NT),(t+2<NT));     ENDW(t+1); RESC(); ROT();
  }
  STEP(pB0,pB1,pA0,pA1,NT-1,false,false,false); RESC();
  { float sacc=pB0[0]+pB0[1]; _Pragma("unroll") for(int r=2;r<16;++r)sacc+=pB0[r]; _Pragma("unroll") for(int r=0;r<16;++r)sacc+=pB1[r]; l_reg+=sacc;
    pw0=(u32x4){PKW(pB0,0),PKW(pB0,2),PKW(pB0,4),PKW(pB0,6)};pw1=(u32x4){PKW(pB0,8),PKW(pB0,10),PKW(pB0,12),PKW(pB0,14)};pw2=(u32x4){PKW(pB1,0),PKW(pB1,2),PKW(pB1,4),PKW(pB1,6)};pw3=(u32x4){PKW(pB1,8),PKW(pB1,10),PKW(pB1,12),PKW(pB1,14)};
    SBAR(); pv(o,vb0+sl_cur,PAF(0),PAF(1),PAF(2),PAF(3)); }
  #undef PKW
  #undef PAF
  #undef VFR
  #undef PIN
  #undef MX3
  #undef GAPA
  #undef GAPB
  #undef EX
  #undef VRD
  #undef KRD
  #undef STEP
  #undef ENDW
  {auto rr=__builtin_amdgcn_permlane32_swap(__float_as_uint(l_reg),__float_as_uint(l_reg),false,false);l_reg=__uint_as_float(rr[0])+__uint_as_float(rr[1]);}
  if(hi==0)wsf[32+r32]=l_reg;asm volatile("s_waitcnt lgkmcnt(0)":::"memory");
  float rli[16];
  #pragma unroll
  for(int r=0;r<16;++r)rli[r]=__builtin_amdgcn_rcpf(wsf[32+crow(r,hi)]);
  bf16*Ow=O+(rowbase+q0+wid*QBLK)*DM+h*D;
  { bf16*stg=(bf16*)(shm+LDS_OST)+wid*2048;
    #pragma unroll
    for(int r=0;r<16;++r){const int orow=crow(r,hi);
      #pragma unroll
      for(int d0=0;d0<2;++d0)stg[orow*64+d0*32+r32]=__float2bfloat16(o[d0][r]*rli[r]);}
    asm volatile("s_waitcnt lgkmcnt(0)":::"memory");
    const bf16*Gw=GT+(rowbase+q0+wid*QBLK)*DM+h*D;
    u32x4 gv[4];
    #pragma unroll
    for(int i=0;i<4;++i){const int row=i*8+(lane>>3),ch=lane&7; gv[i]=*(const u32x4*)(Gw+(long)row*DM+ch*8);}
    #pragma unroll
    for(int i=0;i<4;++i){const int row=i*8+(lane>>3),ch=lane&7; u32x4 v=*(const u32x4*)(stg+row*64+ch*8);
      #pragma unroll
      for(int e=0;e<4;++e){ const float o0=__uint_as_float(v[e]<<16)*__uint_as_float(gv[i][e]<<16), o1=__uint_as_float(v[e]&0xffff0000u)*__uint_as_float(gv[i][e]&0xffff0000u); v[e]=cvtpk_s(o0,o1); }
      ATTN_STORE16(Ow+(long)row*DM+ch*8,v);} }
  asm volatile("s_waitcnt lgkmcnt(0)\n\ts_barrier":::"memory");
  #undef CINIT
  #undef DMA_K
  #undef DMA_V
  #undef CMASK
  #undef START
  #undef RESC
  #undef ROT
}
constexpr int ATTN_LDS_BYTES=LDS_BYTES;
struct AttnTensors { const bf16* Q; const bf16* K; const bf16* V; bf16* O; const bf16* G; const float* C2; };
struct AttnUnit { int bh; int qb; };
struct StaticOrder {
  int vcu, G;
  __device__ __forceinline__ explicit StaticOrder(int grid,int block):vcu((grid%8==0)?(block%8)*(grid/8)+block/8:block),G(grid){}
  __device__ __forceinline__ bool next(int i,AttnUnit&u)const{ const int bh=vcu+(i>>3)*G; if(bh>=BATCH*NHEAD)return false; u.bh=bh; u.qb=7-(i&7); return true; }
  __device__ __forceinline__ void a_ready(const AttnUnit&)const{}
  __device__ __forceinline__ void done(const AttnUnit&)const{}
};
template<class Sched,int THRL=8> __device__ __forceinline__ void attn_phase(char*lds,const AttnTensors&T,const Sched&S,const int tid){
  AttnUnit u;
  for(int i=0;S.next(i,u);++i){ S.a_ready(u); attn_unit<THRL>(u.bh/NHEAD,u.bh%NHEAD,u.qb,T.Q,T.K,T.V,T.O,T.G,T.C2,(i&7)==0,lds,tid); S.done(u); }
}
#undef SBAR
#undef WAIT_BAR
}
constexpr int NWAVES = 8;
constexpr int BATCH = 16, SEQ = 2048, D = 1024, NH = 16, FF = 2816, FF2 = 2 * FF;
constexpr int M = BATCH * SEQ;
constexpr int NKV = 2304;
constexpr float RMS_EPS = 1e-6f;
static_assert(attn_body::BATCH == BATCH && attn_body::SEQ == SEQ && attn_body::DM == D, "attention body geometry");
constexpr size_t MiB = 1u << 20;
constexpr size_t WS_WFI = 2 * MiB;
constexpr size_t WS_WFO = 46 * MiB;
constexpr size_t WS_WCI = 68 * MiB;
constexpr size_t WS_WCO = 74 * MiB;
constexpr size_t WS_WKV = 76 * MiB;
constexpr size_t WS_WQG = 81 * MiB;
constexpr size_t WS_WO = 85 * MiB;
constexpr size_t WS_FL = 88 * MiB;
constexpr size_t WS_C2 = 90 * MiB;
constexpr size_t WS_XH = 96 * MiB;
constexpr size_t WS_R = 160 * MiB;
constexpr size_t WS_K = 352 * MiB, WS_V = 416 * MiB, WS_END = 480 * MiB;
static_assert(WS_WFI + 4 * (size_t)FF2 * D * 2 <= WS_WFO && WS_WFO + 4 * (size_t)D * FF * 2 <= WS_WCI && WS_WKV + (size_t)NKV * D * 2 <= WS_WQG && WS_R + (size_t)M * FF * 2 <= WS_K, "d_ws map");
constexpr int RING_BYTES = 131072, LDS_BYTES = 147456;
static_assert(attn_body::ATTN_LDS_BYTES <= RING_BYTES && pg8::STAGE_BYTES <= RING_BYTES, "LDS map");

#define GAS __attribute__((address_space(1)))
#define LAS __attribute__((address_space(3)))
typedef unsigned short bf16;
typedef unsigned v4u __attribute__((ext_vector_type(4)));
typedef unsigned v2u __attribute__((ext_vector_type(2)));
typedef float f32x4 __attribute__((ext_vector_type(4)));
#define LDS_WAIT() asm volatile("s_waitcnt lgkmcnt(0)" ::: "memory")
__device__ __forceinline__ unsigned f2bf(float f) { unsigned u = __builtin_bit_cast(unsigned, f); return (u + 0x7fffu + ((u >> 16) & 1u)) >> 16; }
__device__ __forceinline__ unsigned pk2(float lo, float hi) { return f2bf(lo) | (f2bf(hi) << 16); }
__device__ __forceinline__ float bflo(unsigned w) { return __uint_as_float(w << 16); }
__device__ __forceinline__ float bfhi(unsigned w) { return __uint_as_float(w & 0xffff0000u); }

struct Frame { LAS unsigned char* lds; int tid, lane, wave, vcu, G; };

__device__ __forceinline__ float wave_sum(float v) {
#pragma unroll
    for (int o = 1; o < 64; o <<= 1) v += __shfl_xor(v, o);
    return v;
}
enum { MAP_PLAIN = 0, MAP_SWIGLU = 1, MAP_CONV = 2 };
__device__ __forceinline__ int map_row(int mode, int n0) {
    if (mode == MAP_SWIGLU) { const int up = n0 >= FF ? 1 : 0, j = n0 - up * FF; return 256 * (j >> 7) + 128 * up + (j & 127); }
    if (mode == MAP_CONV) { if (n0 < D) return 2 * D + n0; const int hh = n0 >= 2 * D ? 1 : 0, j = n0 - D - hh * D; return 256 * (j >> 7) + 128 * hh + (j & 127); }
    return n0;
}
__device__ __forceinline__ void cvt_item(const float* W, int ldw, int K, int ncols, const float* gain, bf16* WT, int mode, LAS float* scr, int item, int lane) {
    const int nblk = ncols / 32, kb = item / nblk, nb = item % nblk, k0 = 64 * kb, n0 = 32 * nb;
#pragma unroll 8
    for (int i = 0; i < 32; ++i) { const int kk = 2 * i + (lane >> 5); scr[kk * 33 + (lane & 31)] = W[(size_t)(k0 + kk) * ldw + n0 + (lane & 31)]; }
    const int c = lane & 7, drow = map_row(mode, n0);
    f32x4 g0 = (f32x4){1.f, 1.f, 1.f, 1.f}, g1 = g0;
    if (gain) { g0 = *(const f32x4*)(gain + k0 + 8 * c); g1 = *(const f32x4*)(gain + k0 + 8 * c + 4); }
    LDS_WAIT(); asm volatile("" ::: "memory");
#pragma unroll
    for (int j = 0; j < 4; ++j) { const int n = (lane >> 3) + 8 * j; const LAS float* s = scr + (8 * c) * 33 + n;
        v4u o; o.x = pk2(s[0 * 33] * g0[0], s[1 * 33] * g0[1]); o.y = pk2(s[2 * 33] * g0[2], s[3 * 33] * g0[3]); o.z = pk2(s[4 * 33] * g1[0], s[5 * 33] * g1[1]); o.w = pk2(s[6 * 33] * g1[2], s[7 * 33] * g1[3]);
        *(GAS v4u*)(WT + (size_t)(drow + n) * K + k0 + 8 * c) = o; }
    LDS_WAIT(); asm volatile("" ::: "memory");
}
struct Ptrs {
    const float *x, *ffn1_pre_g, *ffn1_post_g, *ffn1_w_in, *ffn1_w_out, *mix_pre_g, *mix_post_g, *ffn2_pre_g, *ffn2_post_g, *ffn2_w_in, *ffn2_w_out,
                *conv_w_in, *conv_k, *conv_w_out, *kv_g, *kv_w, *forget_b, *attn_w_qg, *attn_w_o;
};
__device__ __forceinline__ void convert_weights(const Frame& F, const Ptrs& P, unsigned char* ws) {
    LAS float* scr = (LAS float*)(F.lds + F.wave * 16384);
    const int gw = F.vcu * NWAVES + F.wave, NGW = F.G * NWAVES;
    constexpr int I_FI = (D / 64) * (FF2 / 32), I_FO = (FF / 64) * (D / 32), I_CI = (D / 64) * (3 * D / 32), I_DD = (D / 64) * (D / 32), I_2D = (D / 64) * (2 * D / 32);
    constexpr int NITEMS = 4 * I_FI + 4 * I_FO + I_CI + I_DD + I_2D + I_2D + I_DD;
    for (int it = gw; it < NITEMS; it += NGW) {
        int r = it;
        if (r < 4 * I_FI) { const int i = r / I_FI, l = i >> 1, w2 = i & 1; r -= i * I_FI;
            cvt_item((w2 ? P.ffn2_w_in : P.ffn1_w_in) + (size_t)l * D * FF2, FF2, D, FF2, (w2 ? P.ffn2_pre_g : P.ffn1_pre_g) + l * D, (bf16*)(ws + WS_WFI) + (size_t)i * FF2 * D, MAP_SWIGLU, scr, r, F.lane); continue; }
        r -= 4 * I_FI;
        if (r < 4 * I_FO) { const int i = r / I_FO, l = i >> 1, w2 = i & 1; r -= i * I_FO;
            cvt_item((w2 ? P.ffn2_w_out : P.ffn1_w_out) + (size_t)l * FF * D, D, FF, D, nullptr, (bf16*)(ws + WS_WFO) + (size_t)i * D * FF, MAP_PLAIN, scr, r, F.lane); continue; }
        r -= 4 * I_FO;
        if (r < I_CI) { cvt_item(P.conv_w_in, 3 * D, D, 3 * D, P.mix_pre_g, (bf16*)(ws + WS_WCI), MAP_CONV, scr, r, F.lane); continue; } r -= I_CI;
        if (r < I_DD) { cvt_item(P.conv_w_out, D, D, D, nullptr, (bf16*)(ws + WS_WCO), MAP_PLAIN, scr, r, F.lane); continue; } r -= I_DD;
        if (r < I_2D) { cvt_item(P.kv_w, 2 * D + NH, D, 2 * D, P.kv_g, (bf16*)(ws + WS_WKV), MAP_PLAIN, scr, r, F.lane); continue; } r -= I_2D;
        if (r < I_2D) { cvt_item(P.attn_w_qg, 2 * D, D, 2 * D, P.mix_pre_g + D, (bf16*)(ws + WS_WQG), MAP_PLAIN, scr, r, F.lane); continue; } r -= I_2D;
        cvt_item(P.attn_w_o, D, D, D, nullptr, (bf16*)(ws + WS_WO), MAP_PLAIN, scr, r, F.lane);
    }
    bf16* wkv = (bf16*)(ws + WS_WKV);
    const int gt = F.vcu * (NWAVES * 64) + F.tid, NGT = F.G * NWAVES * 64;
    for (int e = gt; e < NH * D; e += NGT) { const int n = e / D, k = e % D; wkv[(size_t)(2 * D + n) * D + k] = (bf16)f2bf(P.kv_w[(size_t)k * (2 * D + NH) + 2 * D + n] * P.kv_g[k]); }
    unsigned* wz = (unsigned*)(wkv + (size_t)(2 * D + NH) * D);
    for (int e = gt; e < (NKV - 2 * D - NH) * D / 2; e += NGT) wz[e] = 0u;
}
__device__ __forceinline__ void thin_phase(const Frame& F, const float* xin, float* xout, const bf16* hb, const float* gpost, float w, bf16* xn, int flags) {
    constexpr int R = 4;
    const int gw = F.vcu * NWAVES + F.wave, NGW = F.G * NWAVES, lane = F.lane;
    const bool has_h = flags & 1, wr_xn = flags & 2, wr_x = flags & 4;
    f32x4 gp[4];
#pragma unroll
    for (int j = 0; j < 4; ++j) gp[j] = has_h ? *(const GAS f32x4*)(gpost + 4 * lane + 256 * j) * w : (f32x4){0.f, 0.f, 0.f, 0.f};
    for (long base = (long)gw * R; base < M; base += (long)NGW * R) {
        f32x4 xv[R][4]; v2u hv[R][4];
#pragma unroll
        for (int r = 0; r < R; ++r)
#pragma unroll
            for (int j = 0; j < 4; ++j) xv[r][j] = *(const GAS f32x4*)(xin + (size_t)(base + r) * D + 4 * lane + 256 * j);
        if (has_h) {
#pragma unroll
            for (int r = 0; r < R; ++r)
#pragma unroll
                for (int j = 0; j < 4; ++j) hv[r][j] = *(const GAS v2u*)(hb + (size_t)(base + r) * D + 4 * lane + 256 * j);
        }
#pragma unroll
        for (int r = 0; r < R; ++r) {
            if (has_h) {
                f32x4 h[4]; float ss = 0.f;
#pragma unroll
                for (int j = 0; j < 4; ++j) { h[j] = (f32x4){bflo(hv[r][j].x), bfhi(hv[r][j].x), bflo(hv[r][j].y), bfhi(hv[r][j].y)}; ss += (h[j].x * h[j].x + h[j].y * h[j].y) + (h[j].z * h[j].z + h[j].w * h[j].w); }
                const float rh = 1.0f / sqrtf(wave_sum(ss) * (1.0f / D) + RMS_EPS);
#pragma unroll
                for (int j = 0; j < 4; ++j) xv[r][j] += h[j] * rh * gp[j];
            }
            if (wr_x) {
#pragma unroll
                for (int j = 0; j < 4; ++j) *(GAS f32x4*)(xout + (size_t)(base + r) * D + 4 * lane + 256 * j) = xv[r][j];
            }
            if (wr_xn) {
                float s2 = 0.f;
#pragma unroll
                for (int j = 0; j < 4; ++j) s2 += (xv[r][j].x * xv[r][j].x + xv[r][j].y * xv[r][j].y) + (xv[r][j].z * xv[r][j].z + xv[r][j].w * xv[r][j].w);
                const float r2 = 1.0f / sqrtf(wave_sum(s2) * (1.0f / D) + RMS_EPS);
#pragma unroll
                for (int j = 0; j < 4; ++j) { v2u o; o.x = pk2(xv[r][j].x * r2, xv[r][j].y * r2); o.y = pk2(xv[r][j].z * r2, xv[r][j].w * r2); *(GAS v2u*)(xn + (size_t)(base + r) * D + 4 * lane + 256 * j) = o; }
            }
        }
    }
}
__device__ __forceinline__ void conv_phase(const Frame& F, const bf16* U, const bf16* Bg, const float* ck, bf16* Z) {
    constexpr int RB = 16;
    const int gw = F.vcu * NWAVES + F.wave, NGW = F.G * NWAVES, lane = F.lane;
    for (int it = gw; it < (M / RB) * 2; it += NGW) {
        const int r0 = (it >> 1) * RB, c0 = (it & 1) * 512 + lane * 8;
        float kw[3][8];
#pragma unroll
        for (int wq = 0; wq < 3; ++wq) { const f32x4 a = *(const f32x4*)(ck + wq * D + c0), b = *(const f32x4*)(ck + wq * D + c0 + 4);
            kw[wq][0] = a.x; kw[wq][1] = a.y; kw[wq][2] = a.z; kw[wq][3] = a.w; kw[wq][4] = b.x; kw[wq][5] = b.y; kw[wq][6] = b.z; kw[wq][7] = b.w; }
        const bool first = (r0 % SEQ) == 0;
        v4u u2 = (v4u){0u, 0u, 0u, 0u}, u1 = u2;
        if (!first) { u2 = *(const GAS v4u*)(U + (size_t)(r0 - 2) * D + c0); u1 = *(const GAS v4u*)(U + (size_t)(r0 - 1) * D + c0); }
#pragma unroll 4
        for (int r = 0; r < RB; ++r) {
            const v4u u0 = *(const GAS v4u*)(U + (size_t)(r0 + r) * D + c0), bg = *(const GAS v4u*)(Bg + (size_t)(r0 + r) * D + c0);
            v4u o;
#pragma unroll
            for (int e = 0; e < 4; ++e) {
                const float ylo = kw[0][2 * e] * bflo(u2[e]) + kw[1][2 * e] * bflo(u1[e]) + kw[2][2 * e] * bflo(u0[e]);
                const float yhi = kw[0][2 * e + 1] * bfhi(u2[e]) + kw[1][2 * e + 1] * bfhi(u1[e]) + kw[2][2 * e + 1] * bfhi(u0[e]);
                o[e] = pk2(ylo * bflo(bg[e]), yhi * bfhi(bg[e]));
            }
            *(GAS v4u*)(Z + (size_t)(r0 + r) * D + c0) = o;
            u2 = u1; u1 = u0;
        }
    }
}
__device__ __forceinline__ void cumsum_phase(const Frame& F, const float* FL, const float* fb, float* C2) {
    if (F.wave != 0) return;
    for (int bh = F.vcu; bh < BATCH * NH; bh += F.G) {
        const int b = bh / NH, h = bh % NH; const float bias = fb[h]; float carry = 0.f;
        for (int j = 0; j < SEQ / 64; ++j) {
            const int t = 64 * j + F.lane; const float xl = FL[((size_t)b * SEQ + t) * NH + h] + bias;
            float v = fminf(xl, 0.f) - log1pf(expf(-fabsf(xl)));
#pragma unroll
            for (int o = 1; o < 64; o <<= 1) { const float y = __shfl_up(v, o); if (F.lane >= o) v += y; }
            v += carry; C2[(size_t)bh * SEQ + t] = v * 1.4426950408889634f; carry = __shfl(v, 63);
        }
    }
}

struct Args { const float* in[19]; float* out; unsigned char* ws; };
__global__ void __launch_bounds__(NWAVES * 64, 2) yoco_fwd(Args args) {
    extern __shared__ __attribute__((aligned(16))) unsigned char lds[];
    cg::grid_group grid = cg::this_grid();
    Frame F;
    F.lds = (LAS unsigned char*)lds; F.tid = threadIdx.x; F.lane = F.tid & 63; F.wave = __builtin_amdgcn_readfirstlane(F.tid >> 6);
    F.G = gridDim.x; { const int bx = blockIdx.x; F.vcu = (F.G % 8 == 0) ? (bx % 8) * (F.G / 8) + bx / 8 : bx; }
    Ptrs P;
    P.x = args.in[0]; P.ffn1_pre_g = args.in[1]; P.ffn1_post_g = args.in[2]; P.ffn1_w_in = args.in[3]; P.ffn1_w_out = args.in[4]; P.mix_pre_g = args.in[5]; P.mix_post_g = args.in[6];
    P.ffn2_pre_g = args.in[7]; P.ffn2_post_g = args.in[8]; P.ffn2_w_in = args.in[9]; P.ffn2_w_out = args.in[10]; P.conv_w_in = args.in[11]; P.conv_k = args.in[12]; P.conv_w_out = args.in[13];
    P.kv_g = args.in[14]; P.kv_w = args.in[15]; P.forget_b = args.in[16]; P.attn_w_qg = args.in[17]; P.attn_w_o = args.in[18];
    float* out = args.out; unsigned char* ws = args.ws;
    bf16* const XH = (bf16*)(ws + WS_XH); bf16* const RH = (bf16*)(ws + WS_R);
    bf16* const Ub = RH; bf16* const Bgb = RH + (size_t)M * D; bf16* const Zb = RH + 2 * (size_t)M * D;
    bf16* const Qb = RH; bf16* const Gtb = RH + (size_t)M * D;
    bf16* const Kb = (bf16*)(ws + WS_K); bf16* const Vb = (bf16*)(ws + WS_V);
    bf16* const WFI = (bf16*)(ws + WS_WFI); bf16* const WFO = (bf16*)(ws + WS_WFO);
    float* const FL = (float*)(ws + WS_FL); float* const C2 = (float*)(ws + WS_C2);

    enum { K_GEMM = 0, K_THIN = 1, K_CONV = 2, K_ATT = 3 };
    constexpr int NPH = 21;
    struct PhaseDesc { unsigned long long p0, p1, p2, p3; int kind, mode, N, K, ldc, flags; float w; int sync; };
    LAS unsigned* const tabw = (LAS unsigned*)(F.lds + RING_BYTES + 1024);
#define TAB_PUT(i, d) do { LAS unsigned* t_ = tabw + 16 * (i); t_[0] = (unsigned)(d).p0; t_[1] = (unsigned)((d).p0 >> 32); t_[2] = (unsigned)(d).p1; t_[3] = (unsigned)((d).p1 >> 32); t_[4] = (unsigned)(d).p2; t_[5] = (unsigned)((d).p2 >> 32); \
        t_[6] = (unsigned)(d).p3; t_[7] = (unsigned)((d).p3 >> 32); t_[8] = (unsigned)(d).kind; t_[9] = (unsigned)(d).mode; t_[10] = (unsigned)(d).N; t_[11] = (unsigned)(d).K; t_[12] = (unsigned)(d).ldc; t_[13] = (unsigned)(d).flags; \
        t_[14] = __float_as_uint((d).w); t_[15] = (unsigned)(d).sync; } while (0)
    if (F.tid == 0) {
#define PD_GEMM(i, A_, B_, N_, K_, mode_, O0_, O1_, ldc_, sync_) do { PhaseDesc d; d.p0 = (unsigned long long)(A_); d.p1 = (unsigned long long)(B_); d.p2 = (unsigned long long)(O0_); d.p3 = (unsigned long long)(O1_); \
        d.kind = K_GEMM; d.mode = (mode_); d.N = (N_); d.K = (K_); d.ldc = (ldc_); d.flags = 0; d.w = 0.f; d.sync = (sync_); TAB_PUT(i, d); } while (0)
#define PD_THIN(i, xin_, g_, w_, flags_, cums_, sync_) do { PhaseDesc d; d.p0 = (unsigned long long)(xin_); d.p1 = (unsigned long long)(g_); d.p2 = 0; d.p3 = 0; \
        d.kind = K_THIN; d.mode = (cums_); d.N = 0; d.K = 0; d.ldc = 0; d.flags = (flags_); d.w = (w_); d.sync = (sync_); TAB_PUT(i, d); } while (0)
#define PD_OTHER(i, kind_) do { PhaseDesc d; d.p0 = 0; d.p1 = 0; d.p2 = 0; d.p3 = 0; d.kind = (kind_); d.mode = 0; d.N = 0; d.K = 0; d.ldc = 0; d.flags = 0; d.w = 0.f; d.sync = 1; TAB_PUT(i, d); } while (0)
#define PD_UP(i, j)   PD_GEMM(i, XH, WFI + (size_t)(j) * FF2 * D, FF2, D, pg8::EM_SWIGLU, RH, 0, FF, 1)
#define PD_DOWN(i, j) PD_GEMM(i, RH, WFO + (size_t)(j) * D * FF, D, FF, pg8::EM_PLAIN, XH, 0, D, 1)
        PD_UP(0, 0); PD_DOWN(1, 0);
        PD_THIN(2, P.x, P.ffn1_post_g, 0.5f, 7, 0, 1);
        PD_GEMM(3, XH, ws + WS_WCI, 3 * D, D, pg8::EM_CONV, Ub, Bgb, D, 1);
        PD_OTHER(4, K_CONV);
        PD_GEMM(5, Zb, ws + WS_WCO, D, D, pg8::EM_PLAIN, XH, 0, D, 1);
        PD_THIN(6, out, P.mix_post_g, 1.0f, 7, 0, 1);
        PD_UP(7, 1); PD_DOWN(8, 1);
        PD_THIN(9, out, P.ffn2_post_g, 0.5f, 7, 0, 1);
        PD_GEMM(10, XH, ws + WS_WKV, NKV, D, pg8::EM_KV, Kb, Vb, D, 0);
        PD_UP(11, 2); PD_DOWN(12, 2);
        PD_THIN(13, out, P.ffn1_post_g + D, 0.5f, 7, 1, 1);
        PD_GEMM(14, XH, ws + WS_WQG, 2 * D, D, pg8::EM_QG, Qb, Gtb, D, 1);
        PD_OTHER(15, K_ATT);
        PD_GEMM(16, Qb, ws + WS_WO, D, D, pg8::EM_PLAIN, XH, 0, D, 1);
        PD_THIN(17, out, P.mix_post_g + D, 1.0f, 7, 0, 1);
        PD_UP(18, 3); PD_DOWN(19, 3);
        PD_THIN(20, out, P.ffn2_post_g + D, 0.5f, 5, 0, 0);
#undef PD_GEMM
#undef PD_THIN
#undef PD_OTHER
#undef PD_UP
#undef PD_DOWN
    }
    convert_weights(F, P, ws);
    thin_phase(F, P.x, out, XH, nullptr, 0.f, XH, 2);
    const float* const conv_k = P.conv_k; const float* const forget_b = P.forget_b;
    grid.sync();
#define RFL(v) __builtin_amdgcn_readfirstlane((int)(v))
#define RFL64(v) (((unsigned long long)(unsigned)RFL((v) >> 32) << 32) | (unsigned long long)(unsigned)RFL((v) & 0xffffffffull))
    const int wave0 = F.wave, bx0 = (int)blockIdx.x, vcu0 = F.vcu;
    for (int ph = 0; ph < NPH; ++ph) {
        int tid, bx = bx0, vcu = vcu0; asm volatile("v_mbcnt_lo_u32_b32 %0, -1, 0\n\tv_mbcnt_hi_u32_b32 %0, -1, %0" : "=v"(tid)); asm volatile("" : "+s"(bx), "+s"(vcu));
        tid += wave0 * 64;
        F.tid = tid; F.lane = tid & 63; F.wave = __builtin_amdgcn_readfirstlane(tid >> 6); F.vcu = vcu;
        const LAS unsigned* const td = tabw + 16 * ph;
#define TD32(k) RFL(td[k])
#define TD64(k) (((unsigned long long)(unsigned)TD32((k) + 1) << 32) | (unsigned long long)(unsigned)TD32(k))
        const int kind = TD32(8);
        if (kind == K_GEMM) {
            pg8::Gemm g{(const bf16*)TD64(0), (const bf16*)TD64(2), M, TD32(10), TD32(11)};
            pg8::EpiMulti E{TD32(9), (pg8::EpiMulti::gbf)TD64(4), (pg8::EpiMulti::gbf)TD64(6), (pg8::EpiMulti::gf32)FL, TD32(12), attn_body::C2};
            pg8::StaticOrder S; S.init(g.M, g.N, F.G, bx);
            pg8::gemm_phase<pg8::EpiMulti, pg8::StaticOrder, true, true>(F.lds, g, S, E, tid);
        } else if (kind == K_THIN) {
            if (TD32(9)) cumsum_phase(F, FL, forget_b, C2);
            thin_phase(F, (const float*)TD64(0), out, XH, (const float*)TD64(2), __uint_as_float((unsigned)TD32(14)), XH, TD32(13));
        } else if (kind == K_CONV) {
            conv_phase(F, Ub, Bgb, conv_k, Zb);
        } else {
            const attn_body::AttnTensors AT{(const attn_body::bf16*)Qb, (const attn_body::bf16*)Kb, (const attn_body::bf16*)Vb, (attn_body::bf16*)Qb, (const attn_body::bf16*)Gtb, C2};
            const attn_body::StaticOrder S((int)F.G, bx);
            attn_body::attn_phase<attn_body::StaticOrder>((char*)lds, AT, S, tid);
        }
        asm volatile("" ::: "memory");
        if (TD32(15)) grid.sync();
    }
#undef TD32
#undef TD64
#undef RFL
#undef RFL64
}

extern "C" void kernel_launch(void* const* d_in, const int* in_sizes, int n_in, void* d_out, int out_size, void* d_ws, size_t ws_size, hipStream_t stream) {
    static int grid = 0;
    if (grid == 0) {
        if (n_in != 19 || in_sizes[0] != M * D || out_size != M * D || ws_size < WS_END) { fprintf(stderr, "kernel_launch: unexpected shapes (n_in %d, in0 %d, out %d, ws %zu); nothing launched\n", n_in, n_in > 0 ? in_sizes[0] : -1, out_size, ws_size); grid = -1; return; }
        int dev = 0, cus = 0, per_cu = 0;
        if (hipGetDevice(&dev) != hipSuccess || hipDeviceGetAttribute(&cus, hipDeviceAttributeMultiprocessorCount, dev) != hipSuccess) { fprintf(stderr, "kernel_launch: device query failed\n"); grid = -1; return; }
        if (hipFuncSetAttribute((const void*)yoco_fwd, hipFuncAttributeMaxDynamicSharedMemorySize, LDS_BYTES) != hipSuccess) { fprintf(stderr, "kernel_launch: hipFuncSetAttribute failed\n"); grid = -1; return; }
        if (hipOccupancyMaxActiveBlocksPerMultiprocessor(&per_cu, (const void*)yoco_fwd, NWAVES * 64, LDS_BYTES) != hipSuccess || per_cu < 1) { fprintf(stderr, "kernel_launch: occupancy query says %d blocks per CU\n", per_cu); per_cu = 1; }
        (void)hipGetLastError();
        grid = cus * per_cu;
    }
    if (grid < 0) return;
    Args a{};
    for (int i = 0; i < 19; ++i) a.in[i] = (const float*)d_in[i];
    a.out = (float*)d_out; a.ws = (unsigned char*)d_ws;
    void* kargs[] = {&a};
    const hipError_t e = hipLaunchCooperativeKernel((const void*)yoco_fwd, dim3(grid), dim3(NWAVES * 64), kargs, LDS_BYTES, stream);
    if (e != hipSuccess) fprintf(stderr, "kernel_launch: cooperative launch failed: %s (grid %d)\n", hipGetErrorString(e), grid);
}
```

```cpp
#include <hip/hip_runtime.h>
#include <hip/hip_cooperative_groups.h>
#include <cstdio>
#include <cstdint>
namespace cg = cooperative_groups;
namespace pg8 {
#define PG8_LAS __attribute__((address_space(3)))
typedef unsigned short bf16_t;
typedef short bf16x8 __attribute__((ext_vector_type(8)));
typedef float f32x4 __attribute__((ext_vector_type(4)));
typedef unsigned u32x4 __attribute__((ext_vector_type(4)));
constexpr int BM = 256, BK = 64, HALF = 128, HTB = HALF * BK * 2  , STAGE_BYTES = 8 * HTB, NXCD = 8, WGM = 8;

__host__ __device__ __forceinline__ int lds_byte(int r, int c) { const int st = (r >> 4) * 2 + (c >> 5), rr = r & 15, cc = c & 31, ob = rr * 64 + cc * 2; return st * 1024 + (ob ^ (((ob >> 9) & 1) << 5)); }
__host__ __device__ __forceinline__ void stage_rc(int b, int& R, int& C) { const int st = b / 1024, sb = b % 1024, swz = sb ^ (((sb >> 9) & 1) << 5); R = (st >> 1) * 16 + swz / 64; C = (st & 1) * 32 + (swz % 64) / 2; }
__host__ __device__ __forceinline__ int perm32(int rho) { const int n = rho >> 4, i = rho & 15; return 8 * (i >> 2) + 4 * n + (i & 3); }

struct Unit { int pm, pn; };
struct Gemm { const bf16_t* A; const bf16_t* Bt; int M, N, K; };

struct StaticOrder {
    int nM, nN, nwg, G, c;
    __host__ __device__ void init(int M, int N, int G_, int c_) { nM = M / BM; nN = N / BM; nwg = nM * nN; G = G_; c = c_; }
    __host__ __device__ bool next(int i, Unit& u) const {
        const long L = (long)i * G + c; if (L >= nwg) return false;
        int wgid = (int)L; { const int q = nwg / NXCD, r = nwg % NXCD, xcd = wgid % NXCD, off = wgid / NXCD; wgid = (xcd < r ? xcd * (q + 1) : r * (q + 1) + (xcd - r) * q) + off; }
        const int nig = WGM * nN, gid = wgid / nig, fm = gid * WGM, gsz = (nM - fm) < WGM ? (nM - fm) : WGM;
        u.pm = fm + ((wgid % nig) % gsz); u.pn = (wgid % nig) / gsz; return true;
    }
    __device__ __forceinline__ void a_ready(const Unit&) const {}
    __device__ __forceinline__ void done(const Unit&) const {}
};

__device__ __forceinline__ unsigned cvt_pk_bf16(float lo, float hi) { unsigned r; asm volatile("v_cvt_pk_bf16_f32 %0, %1, %2" : "=v"(r) : "v"(lo), "v"(hi)); return r; }
typedef float f32x2 __attribute__((ext_vector_type(2)));
template <class Epi, class Sched, bool ALIGN_EPI = false, bool SP2 = false>
__device__ __forceinline__ void gemm_phase(PG8_LAS unsigned char* lds, const Gemm g, const Sched& S, const Epi& E, const int tid) {
    const int wid = __builtin_amdgcn_readfirstlane(tid >> 6), lane = tid & 63, wr = wid >> 2, wc = wid & 3, fr = lane & 15, fq = lane >> 4;
    const int K = g.K, nt = K / BK;
    unsigned voffA[2], voffB[2];
#pragma unroll
    for (int i = 0; i < 2; ++i) { int R, C; stage_rc(tid * 16 + i * 8192, R, C); const int Rb = Epi::PERM ? ((R & ~31) + perm32(R & 31)) : R;
        voffA[i] = (unsigned)(R * K + C) * 2u; voffB[i] = (unsigned)(Rb * K + C) * 2u; }
    const size_t kstep = (size_t)(BK * 2);
    const size_t hstep = (size_t)HALF * K * 2;
    const size_t tstep = 2 * hstep;
    const unsigned ldsw = (unsigned)wid * 1024u;
    const int aoff = lds_byte(wr * 64 + fr, fq * 8), boff = lds_byte(wc * 32 + fr, fq * 8);
#define PG8_SA(b, h) (((b) * 2 + (h)) * HTB)
#define PG8_SB(b, h) ((4 + (b) * 2 + (h)) * HTB)
#define PG8_STAGE(bufoff, gbase, voff) do { _Pragma("unroll") for (int _i = 0; _i < 2; ++_i) \
        __builtin_amdgcn_global_load_lds((const unsigned*)((const char*)(gbase) + (voff)[_i]), (PG8_LAS unsigned*)(lds + (bufoff) + ldsw + _i * 8192), 16, 0, 0); } while (0)
#define PG8_LDA(dst, b, h) do { _Pragma("unroll") for (int m = 0; m < 4; ++m) _Pragma("unroll") for (int k = 0; k < 2; ++k) dst[m][k] = *(const PG8_LAS bf16x8*)(lds + PG8_SA(b, h) + aoff + m * 2048 + k * 1024); } while (0)
#define PG8_LDB(dst, b, h) do { _Pragma("unroll") for (int n = 0; n < 2; ++n) _Pragma("unroll") for (int k = 0; k < 2; ++k) dst[n][k] = *(const PG8_LAS bf16x8*)(lds + PG8_SB(b, h) + boff + n * 2048 + k * 1024); } while (0)
#define PG8_MMA(ai, bj, At, Bt) do { __builtin_amdgcn_s_setprio(1); _Pragma("unroll") for (int m = 0; m < 4; ++m) _Pragma("unroll") for (int n = 0; n < 2; ++n) _Pragma("unroll") for (int k = 0; k < 2; ++k) \
        acc[ai][bj][m][n] = __builtin_amdgcn_mfma_f32_16x16x32_bf16(Bt[n][k], At[m][k], acc[ai][bj][m][n], 0, 0, 0); __builtin_amdgcn_s_setprio(0); } while (0)
#define PG8_WAIT_V(n) asm volatile("s_waitcnt vmcnt(" #n ")" ::: "memory")
#define PG8_WAIT_L(n) asm volatile("s_waitcnt lgkmcnt(" #n ")" ::: "memory")
#define PG8_BAR __builtin_amdgcn_s_barrier()
#define PG8_SCHED __builtin_amdgcn_sched_barrier(0)
    Unit cur, nxt; int ui = 0;
    if (!S.next(0, cur)) return;
    f32x4 acc[2][2][4][2];
#pragma unroll
    for (int a = 0; a < 2; ++a)
#pragma unroll
        for (int b = 0; b < 2; ++b)
#pragma unroll
            for (int m = 0; m < 4; ++m)
#pragma unroll
                for (int n = 0; n < 2; ++n) acc[a][b][m][n] = (f32x4){0.f, 0.f, 0.f, 0.f};
    bf16x8 At[4][2], B0[2][2], B1[2][2];
    const char* cA = (const char*)g.A + (size_t)cur.pm * tstep; const char* cB = (const char*)g.Bt + (size_t)cur.pn * tstep;
    S.a_ready(cur);
    if constexpr (SP2) {
        PG8_STAGE(PG8_SB(0, 0), cB, voffB); PG8_STAGE(PG8_SB(0, 1), cB + hstep, voffB); PG8_STAGE(PG8_SA(0, 0), cA, voffA); PG8_STAGE(PG8_SA(0, 1), cA + hstep, voffA);
        if (wr == 1) PG8_BAR;
        PG8_WAIT_V(2); PG8_BAR;
        PG8_STAGE(PG8_SB(1, 0), cB + kstep, voffB); PG8_STAGE(PG8_SA(1, 0), cA + kstep, voffA); PG8_STAGE(PG8_SB(1, 1), cB + hstep + kstep, voffB);
        PG8_WAIT_V(6); PG8_BAR;
    } else {
        PG8_STAGE(PG8_SB(0, 0), cB, voffB); PG8_STAGE(PG8_SA(0, 0), cA, voffA); PG8_STAGE(PG8_SB(0, 1), cB + hstep, voffB); PG8_STAGE(PG8_SA(0, 1), cA + hstep, voffA);
        if (wr == 1) PG8_BAR;
        PG8_WAIT_V(4); PG8_BAR;
        PG8_STAGE(PG8_SB(1, 0), cB + kstep, voffB); PG8_STAGE(PG8_SA(1, 0), cA + kstep, voffA); PG8_STAGE(PG8_SB(1, 1), cB + hstep + kstep, voffB);
        PG8_WAIT_V(6); PG8_BAR;
    }
    for (;;) {
        const bool has_next = S.next(ui + 1, nxt);
        const char* nA = has_next ? (const char*)g.A + (size_t)nxt.pm * tstep : cA; const char* nB = has_next ? (const char*)g.Bt + (size_t)nxt.pn * tstep : cB;
        for (int t = 0; t < nt; t += 2) {
            const bool last = (t == nt - 2);
            const char* a1 = cA + (size_t)(t + 1) * kstep;
            const char* a2 = last ? nA : cA + (size_t)(t + 2) * kstep; const char* b2 = last ? nB : cB + (size_t)(t + 2) * kstep;
            const char* a3 = a2 + kstep; const char* b3 = b2 + kstep;
            if (last && has_next) S.a_ready(nxt);
            if constexpr (SP2) {
            PG8_LDB(B0, 0, 0); PG8_LDB(B1, 0, 1); PG8_SCHED; PG8_LDA(At, 0, 0); PG8_STAGE(PG8_SA(1, 1), a1 + hstep, voffA);
            PG8_WAIT_V(8); PG8_WAIT_L(0); PG8_BAR; PG8_MMA(0, 0, At, B0); PG8_MMA(0, 1, At, B1); PG8_BAR; PG8_SCHED;
            PG8_LDA(At, 0, 1); PG8_STAGE(PG8_SB(0, 0), b2, voffB); PG8_STAGE(PG8_SB(0, 1), b2 + hstep, voffB); PG8_STAGE(PG8_SA(0, 0), a2, voffA);
            PG8_WAIT_V(8); PG8_WAIT_L(0); PG8_BAR; PG8_MMA(1, 0, At, B0); PG8_MMA(1, 1, At, B1); PG8_BAR; PG8_SCHED;
            PG8_LDB(B0, 1, 0); PG8_LDB(B1, 1, 1); PG8_SCHED; PG8_LDA(At, 1, 0); PG8_STAGE(PG8_SA(0, 1), a2 + hstep, voffA);
            PG8_WAIT_V(8); PG8_WAIT_L(0); PG8_BAR; PG8_MMA(0, 0, At, B0); PG8_MMA(0, 1, At, B1); PG8_BAR; PG8_SCHED;
            PG8_LDA(At, 1, 1); PG8_STAGE(PG8_SB(1, 0), b3, voffB); PG8_STAGE(PG8_SB(1, 1), b3 + hstep, voffB); PG8_STAGE(PG8_SA(1, 0), a3, voffA);
            PG8_WAIT_V(8); PG8_WAIT_L(0); PG8_BAR; PG8_MMA(1, 0, At, B0); PG8_MMA(1, 1, At, B1); PG8_BAR; PG8_SCHED;
            } else {
            PG8_LDB(B0, 0, 0); PG8_SCHED; PG8_LDA(At, 0, 0); PG8_STAGE(PG8_SA(1, 1), a1 + hstep, voffA);
            PG8_WAIT_L(8); PG8_BAR; PG8_WAIT_L(0); PG8_MMA(0, 0, At, B0); PG8_BAR; PG8_SCHED;
            PG8_LDB(B1, 0, 1); PG8_STAGE(PG8_SB(0, 0), b2, voffB);
            PG8_BAR; PG8_WAIT_L(0); PG8_MMA(0, 1, At, B1); PG8_BAR;
            PG8_LDA(At, 0, 1); PG8_STAGE(PG8_SA(0, 0), a2, voffA);
            PG8_BAR; PG8_WAIT_L(0); PG8_MMA(1, 0, At, B0); PG8_BAR; PG8_SCHED;
            PG8_STAGE(PG8_SB(0, 1), b2 + hstep, voffB);
            PG8_WAIT_V(6); PG8_BAR; PG8_MMA(1, 1, At, B1); PG8_BAR;
            PG8_LDB(B0, 1, 0); PG8_SCHED; PG8_LDA(At, 1, 0); PG8_STAGE(PG8_SA(0, 1), a2 + hstep, voffA);
            PG8_WAIT_L(8); PG8_BAR; PG8_WAIT_L(0); PG8_MMA(0, 0, At, B0); PG8_BAR; PG8_SCHED;
            PG8_LDB(B1, 1, 1); PG8_STAGE(PG8_SB(1, 0), b3, voffB);
            PG8_BAR; PG8_WAIT_L(0); PG8_MMA(0, 1, At, B1); PG8_BAR;
            PG8_LDA(At, 1, 1); PG8_STAGE(PG8_SA(1, 0), a3, voffA);
            PG8_BAR; PG8_WAIT_L(0); PG8_MMA(1, 0, At, B0); PG8_BAR; PG8_SCHED;
            PG8_STAGE(PG8_SB(1, 1), b3 + hstep, voffB);
            PG8_WAIT_V(6); PG8_BAR; PG8_MMA(1, 1, At, B1); PG8_BAR;
            }
        }
        if constexpr (ALIGN_EPI) { if (wr == 0) PG8_BAR; }
        if constexpr (!Epi::AFTER_DRAIN) { E(acc, cur, wr, wc, fr, fq); S.done(cur); }
        if (!has_next) break;
#pragma unroll
        for (int a = 0; a < 2; ++a)
#pragma unroll
            for (int b = 0; b < 2; ++b)
#pragma unroll
                for (int m = 0; m < 4; ++m)
#pragma unroll
                    for (int n = 0; n < 2; ++n) acc[a][b][m][n] = (f32x4){0.f, 0.f, 0.f, 0.f};
        cur = nxt; cA = nA; cB = nB; ++ui;
        if constexpr (ALIGN_EPI) { if (wr == 1) PG8_BAR; }
    }
    PG8_WAIT_V(0);
    if constexpr (!ALIGN_EPI) { if (wr == 0) PG8_BAR; }
    PG8_BAR;
    if constexpr (Epi::AFTER_DRAIN) { E.fused(acc, cur, wr, wc, fr, fq, lds, wid, lane); S.done(cur); }
#undef PG8_SA
#undef PG8_SB
#undef PG8_STAGE
#undef PG8_LDA
#undef PG8_LDB
#undef PG8_MMA
#undef PG8_WAIT_V
#undef PG8_WAIT_L
#undef PG8_BAR
#undef PG8_SCHED
}
}
namespace pg8 {
enum { EM_PLAIN = 0, EM_SWIGLU = 1, EM_CONV = 2, EM_KV = 3, EM_QG = 4 };
struct EpiMulti {
    static constexpr bool PERM = true, AFTER_DRAIN = false;
    typedef __attribute__((address_space(1))) bf16_t* gbf; typedef __attribute__((address_space(1))) float* gf32;
    int mode; gbf O0; gbf O1; gf32 F; int ldc; float qscale; const __attribute__((address_space(1))) float* rs;
    __device__ __forceinline__ static void st8(gbf p, f32x4 v0, f32x4 v1) { u32x4 w; w.x = cvt_pk_bf16(v0[0], v0[1]); w.y = cvt_pk_bf16(v0[2], v0[3]); w.z = cvt_pk_bf16(v1[0], v1[1]); w.w = cvt_pk_bf16(v1[2], v1[3]); *(__attribute__((address_space(1))) u32x4*)p = w; }
    __device__ __forceinline__ static f32x4 sigm(f32x4 g) { f32x4 r;
#pragma unroll
        for (int i = 0; i < 4; ++i) r[i] = __builtin_amdgcn_rcpf(1.0f + __builtin_amdgcn_exp2f(g[i] * -1.4426950408889634f)); return r; }
    __device__ __forceinline__ void operator()(const f32x4 (&acc)[2][2][4][2], const Unit& u, int wr, int wc, int fr, int fq) const {
        const int row0 = u.pm * BM + wr * 64 + fr, cl = wc * 32 + 8 * fq;
        float rv[2][4];
        if (mode != EM_PLAIN) {
#pragma unroll
            for (int ai = 0; ai < 2; ++ai)
#pragma unroll
                for (int m = 0; m < 4; ++m) rv[ai][m] = rs[row0 + ai * HALF + m * 16];
        }
        if (mode == EM_PLAIN) {
#pragma unroll
            for (int ai = 0; ai < 2; ++ai)
#pragma unroll
                for (int m = 0; m < 4; ++m) { gbf rowp = O0 + (size_t)(row0 + ai * HALF + m * 16) * ldc + u.pn * BM + cl;
#pragma unroll
                    for (int bj = 0; bj < 2; ++bj) st8(rowp + bj * HALF, acc[ai][bj][m][0], acc[ai][bj][m][1]); }
        } else if (mode == EM_SWIGLU) {
#pragma unroll
            for (int ai = 0; ai < 2; ++ai)
#pragma unroll
                for (int m = 0; m < 4; ++m) { gbf rowp = O0 + (size_t)(row0 + ai * HALF + m * 16) * ldc + u.pn * HALF + cl;
                    const float r = rv[ai][m]; const f32x4 g0 = acc[ai][0][m][0] * r, g1 = acc[ai][0][m][1] * r;
                    st8(rowp, g0 * sigm(g0) * (acc[ai][1][m][0] * r), g1 * sigm(g1) * (acc[ai][1][m][1] * r)); }
        } else if (mode == EM_CONV) {
            if (u.pn < 8) {
#pragma unroll
                for (int ai = 0; ai < 2; ++ai)
#pragma unroll
                    for (int m = 0; m < 4; ++m) { gbf rowp = O0 + (size_t)(row0 + ai * HALF + m * 16) * ldc + u.pn * HALF + cl;
                        const float r2 = rv[ai][m] * rv[ai][m]; st8(rowp, acc[ai][0][m][0] * acc[ai][1][m][0] * r2, acc[ai][0][m][1] * acc[ai][1][m][1] * r2); }
            } else {
#pragma unroll
                for (int ai = 0; ai < 2; ++ai)
#pragma unroll
                    for (int m = 0; m < 4; ++m) { gbf rowp = O1 + (size_t)(row0 + ai * HALF + m * 16) * ldc + (u.pn - 8) * BM + cl; const float r = rv[ai][m];
#pragma unroll
                        for (int bj = 0; bj < 2; ++bj) st8(rowp + bj * HALF, acc[ai][bj][m][0] * r, acc[ai][bj][m][1] * r); }
            }
        } else if (mode == EM_KV) {
            if (u.pn < 8) { gbf base = (u.pn < 4) ? O0 : O1; const int ct = (u.pn & 3) * BM + cl;
#pragma unroll
                for (int ai = 0; ai < 2; ++ai)
#pragma unroll
                    for (int m = 0; m < 4; ++m) { gbf rowp = base + (size_t)(row0 + ai * HALF + m * 16) * ldc + ct; const float r = rv[ai][m];
#pragma unroll
                        for (int bj = 0; bj < 2; ++bj) st8(rowp + bj * HALF, acc[ai][bj][m][0] * r, acc[ai][bj][m][1] * r); }
            } else if (wc == 0 && fq < 2) {
#pragma unroll
                for (int ai = 0; ai < 2; ++ai)
#pragma unroll
                    for (int m = 0; m < 4; ++m) { gf32 fp = F + (size_t)(row0 + ai * HALF + m * 16) * 16 + 8 * fq;
                        *(__attribute__((address_space(1))) f32x4*)fp = acc[ai][0][m][0] * rv[ai][m]; *(__attribute__((address_space(1))) f32x4*)(fp + 4) = acc[ai][0][m][1] * rv[ai][m]; }
            }
        } else {
            const bool isq = u.pn < 4; gbf base = isq ? O0 : O1; const int ct = (u.pn & 3) * BM + cl;
#pragma unroll
            for (int ai = 0; ai < 2; ++ai)
#pragma unroll
                for (int m = 0; m < 4; ++m) { gbf rowp = base + (size_t)(row0 + ai * HALF + m * 16) * ldc + ct;
#pragma unroll
                    for (int bj = 0; bj < 2; ++bj) { f32x4 v0 = acc[ai][bj][m][0] * rv[ai][m], v1 = acc[ai][bj][m][1] * rv[ai][m];
                        if (isq) { v0 = v0 * qscale; v1 = v1 * qscale; } else { v0 = sigm(v0); v1 = sigm(v1); }
                        st8(rowp + bj * HALF, v0, v1); } }
        }
    }
};
}
#ifndef PG8_SP2
#define PG8_SP2 true
#endif
#include <hip/hip_bf16.h>
#include <cmath>
namespace attn_body {
using bf16=__hip_bfloat16;
using bf16x8=__attribute__((ext_vector_type(8)))short;
using s16x4=__attribute__((ext_vector_type(4)))short;
using f32x16=__attribute__((ext_vector_type(16)))float;
using u32x4=__attribute__((ext_vector_type(4)))unsigned;
using f32x4_t=__attribute__((ext_vector_type(4)))float;
constexpr int BATCH=16,NHEAD=16,SEQ=2048,D=64,DM=NHEAD*D;
constexpr int NW=8,QBLK=32,QB=QBLK*NW,KVBLK=64,NQB=SEQ/QB;
constexpr int ATTN_PITCH=DM, ATTN_UNIT_ROWS=QB;
__device__ __forceinline__ int crow(int r,int hi){return (r&3)+8*(r>>2)+4*hi;}
#define SBAR() __builtin_amdgcn_sched_barrier(0)
__device__ __forceinline__ void cmask(f32x16&p0,f32x16&p1,int jb,int qrel,int hi){
  const float NEG=-INFINITY; int kb=64*jb+4*hi;
  #pragma unroll
  for(int r=0;r<16;++r){int kv=kb+(r&3)+8*(r>>2); if(kv>qrel)p0[r]=NEG; if(kv+32>qrel)p1[r]=NEG;}
}

constexpr int NSLOT=3, SLOTB=8192;
constexpr int LDS_K=0, LDS_V=NSLOT*SLOTB, LDS_WS=2*NSLOT*SLOTB, LDS_OST=LDS_WS+NW*64*4, LDS_CT=LDS_OST+NW*4096, LDS_BYTES=LDS_CT+SEQ*4;
constexpr float C2=0.125f*1.4426950408889634f;
__device__ __forceinline__ void glds16(const void*gsrc,unsigned lds_dst){unsigned keep;
  asm volatile("s_mov_b32 %0, m0\n\ts_mov_b32 m0, %2\n\ts_nop 0\n\tglobal_load_lds_dwordx4 %1, off\n\ts_mov_b32 m0, %0":"=&s"(keep):"v"(gsrc),"s"(lds_dst):"memory");}
__device__ __forceinline__ float max3f(float a,float b,float c){float r;asm("v_max3_f32 %0, %1, %2, %3":"=v"(r):"v"(a),"v"(b),"v"(c));return r;}
__device__ __forceinline__ float max2f(float a,float b){float r;asm("v_max_f32_e32 %0, %1, %2":"=v"(r):"v"(a),"v"(b));return r;}
__device__ __forceinline__ float fadd_s(float a,float b){float r;asm("v_add_f32_e32 %0, %1, %2":"=v"(r):"v"(a),"v"(b));return r;}
__device__ __forceinline__ float fsub_s(float a,float b){float r;asm("v_sub_f32_e32 %0, %1, %2":"=v"(r):"v"(a),"v"(b));return r;}
typedef float f32x2_t __attribute__((ext_vector_type(2))); typedef __bf16 bf16x2_t __attribute__((ext_vector_type(2)));
__device__ __forceinline__ unsigned cvtpk_s(float lo,float hi){f32x2_t v={lo,hi};bf16x2_t b=__builtin_convertvector(v,bf16x2_t);return __builtin_bit_cast(unsigned,b);}
#define WAIT_BAR(N) asm volatile("s_waitcnt vmcnt(" #N ") lgkmcnt(0)\n\ts_barrier":::"memory")

__device__ __forceinline__ void qkt(f32x16&p0,f32x16&p1,const char*Kslot,const bf16x8*qr,int r32,int hi){
  const char*kb=Kslot+hi*1024+r32*16;
  #pragma unroll
  for(int d0=0;d0<4;++d0){
    const bf16x8 b0=*reinterpret_cast<const bf16x8*>(kb+d0*2048);
    const bf16x8 b1=*reinterpret_cast<const bf16x8*>(kb+d0*2048+512);
    p0=__builtin_amdgcn_mfma_f32_32x32x16_bf16(b0,qr[d0],p0,0,0,0);p1=__builtin_amdgcn_mfma_f32_32x32x16_bf16(b1,qr[d0],p1,0,0,0);}
}
typedef __attribute__((address_space(3))) const char* lds_cptr;
typedef short v4i16_t __attribute__((ext_vector_type(4)));
__device__ __forceinline__ void kload8(bf16x8*kf,lds_cptr kp){
  kf[0]=*(const __attribute__((address_space(3))) bf16x8*)(kp);      kf[1]=*(const __attribute__((address_space(3))) bf16x8*)(kp+512);
  kf[2]=*(const __attribute__((address_space(3))) bf16x8*)(kp+2048); kf[3]=*(const __attribute__((address_space(3))) bf16x8*)(kp+2560);
  kf[4]=*(const __attribute__((address_space(3))) bf16x8*)(kp+4096); kf[5]=*(const __attribute__((address_space(3))) bf16x8*)(kp+4608);
  kf[6]=*(const __attribute__((address_space(3))) bf16x8*)(kp+6144); kf[7]=*(const __attribute__((address_space(3))) bf16x8*)(kp+6656);
}
__device__ __forceinline__ void kload2(bf16x8*kf,lds_cptr kp,int j){ kf[2*j]=*(const __attribute__((address_space(3))) bf16x8*)(kp+j*2048); kf[2*j+1]=*(const __attribute__((address_space(3))) bf16x8*)(kp+j*2048+512); }
__device__ __forceinline__ s16x4 vtr(lds_cptr p){ return __builtin_bit_cast(s16x4,__builtin_amdgcn_ds_read_tr16_b64_v4i16((__attribute__((address_space(3))) v4i16_t*)p)); }
__device__ __forceinline__ float rowmax(const f32x16&p0,const f32x16&p1){
  float a=max3f(p0[0],p0[1],p1[0]),b=max3f(p0[2],p0[3],p1[1]);a=max3f(a,p1[2],p1[3]);
  #pragma unroll
  for(int r=4;r<16;r+=4){a=max3f(a,p0[r],p0[r+1]);b=max3f(b,p0[r+2],p0[r+3]);a=max3f(a,p1[r],p1[r+1]);b=max3f(b,p1[r+2],p1[r+3]);}
  const float m=max2f(a,b);
  auto rr=__builtin_amdgcn_permlane32_swap(__float_as_uint(m),__float_as_uint(m),false,false);
  return max2f(__uint_as_float(rr[0]),__uint_as_float(rr[1]));
}
__device__ __forceinline__ void pv(f32x16*o,int vb,bf16x8 pa0,bf16x8 pa1,bf16x8 pa2,bf16x8 pa3){
  #pragma unroll
  for(int d0=0;d0<2;++d0){s16x4 lo[4],hi[4];
    #pragma unroll
    for(int ks=0;ks<4;++ks){
      asm volatile("ds_read_b64_tr_b16 %0,%1 offset:%c2":"=&v"(lo[ks]):"v"(vb),"i"(d0*4096+ks*1024):"memory");
      asm volatile("ds_read_b64_tr_b16 %0,%1 offset:%c2":"=&v"(hi[ks]):"v"(vb),"i"(d0*4096+ks*1024+512):"memory");}
    asm volatile("s_waitcnt lgkmcnt(0)":::"memory");SBAR();
    #define PK(k) (bf16x8){lo[k][0],lo[k][1],lo[k][2],lo[k][3],hi[k][0],hi[k][1],hi[k][2],hi[k][3]}
    o[d0]=__builtin_amdgcn_mfma_f32_32x32x16_bf16(pa0,PK(0),o[d0],0,0,0);
    o[d0]=__builtin_amdgcn_mfma_f32_32x32x16_bf16(pa1,PK(1),o[d0],0,0,0);
    o[d0]=__builtin_amdgcn_mfma_f32_32x32x16_bf16(pa2,PK(2),o[d0],0,0,0);
    o[d0]=__builtin_amdgcn_mfma_f32_32x32x16_bf16(pa3,PK(3),o[d0],0,0,0);
    #undef PK
  }
}

#ifndef ATTN_STORE16
#define ATTN_STORE16(p,v) (*(u32x4*)(p)=(v))
#endif
template<int THRL> __device__ __forceinline__ void attn_unit(int b,int h,int qb,const bf16*Q,const bf16*__restrict__ K,const bf16*__restrict__ V,bf16*O,const bf16*__restrict__ GT,const float*__restrict__ C2T,bool load_ct,char*shm,const int tid){
  const int lane=tid&63,r32=lane&31,hi=lane>>5; const int wid=__builtin_amdgcn_readfirstlane(tid>>6);
  const long rowbase=(long)b*SEQ; const int q0=qb*QB;
  const bf16*Qw=Q+(rowbase+q0+wid*QBLK)*DM+h*D;
  const bf16*Kh=K+rowbase*DM+h*D,*Vh=V+rowbase*DM+h*D;
  const unsigned lds0=(unsigned)(uintptr_t)shm;
  float*wsf=(float*)(shm+LDS_WS)+wid*64;
  typedef __attribute__((address_space(3))) f32x4_t* lds_f4p;
  const float*c2row=C2T+((long)b*NHEAD+h)*SEQ;
  if(load_ct){ const f32x4_t cv=*reinterpret_cast<const f32x4_t*>(c2row+tid*4); asm volatile("s_waitcnt vmcnt(0)":::"memory"); *((lds_f4p)(shm+LDS_CT)+tid)=cv; }
  const float cq=c2row[qb*QB+wid*QBLK+r32];
  const __attribute__((address_space(3))) f32x4_t* ctab=(const __attribute__((address_space(3))) f32x4_t*)(shm+LDS_CT)+hi;
  #define CINIT(P0,P1,t) do{ const __attribute__((address_space(3))) f32x4_t* cp_=ctab+(t)*16; const float nm_=cq-mhat; \
    _Pragma("unroll") for(int j_=0;j_<4;++j_){ const f32x4_t a_=cp_[2*j_], b_=cp_[8+2*j_]; \
      P0[4*j_]=nm_-a_[0];P0[4*j_+1]=nm_-a_[1];P0[4*j_+2]=nm_-a_[2];P0[4*j_+3]=nm_-a_[3]; P1[4*j_]=nm_-b_[0];P1[4*j_+1]=nm_-b_[1];P1[4*j_+2]=nm_-b_[2];P1[4*j_+3]=nm_-b_[3]; } }while(0)
  const bf16*ksrc=Kh+(long)lane*DM+wid*8;
  const bf16*vsrc=Vh+(long)(16*(wid&3)+(lane>>2))*DM+(wid>>2)*32+(lane&3)*8;
  const unsigned kdst=lds0+LDS_K+wid*1024, vdst=lds0+LDS_V+wid*1024;
  #define DMA_K(t,slot) glds16(ksrc+(long)(t)*KVBLK*DM,(unsigned)__builtin_amdgcn_readfirstlane(kdst+(slot)))
  #define DMA_V(t,slot) glds16(vsrc+(long)(t)*KVBLK*DM,(unsigned)__builtin_amdgcn_readfirstlane(vdst+(slot)))
  const int vb0=(int)(lds0+LDS_V)+((lane>>4)&1)*32+(lane&3)*8+(4*hi+((lane&15)>>2))*64;
  const char*Kbase=shm+LDS_K; bf16x8 kf[8];
  const lds_cptr shm3=(lds_cptr)shm; const lds_cptr kp0=shm3+LDS_K+hi*1024+r32*16; const lds_cptr vp0=shm3+LDS_V+((lane>>4)&1)*32+(lane&3)*8+(4*hi+((lane&15)>>2))*64;
  const int NT=(q0+QB)/KVBLK;
  DMA_K(0,0);DMA_V(0,0);DMA_K(1,SLOTB);
  bf16x8 qr[4];
  #pragma unroll
  for(int d0=0;d0<4;++d0)qr[d0]=*reinterpret_cast<const bf16x8*>(&Qw[(long)r32*DM+d0*16+hi*8]);
  float mhat=0.f,l_reg=0.f;f32x16 o[2];o[0]=f32x16{};o[1]=f32x16{};
  const int qrel=wid*QBLK+r32;
  #define CMASK(P0,P1,t) do{int jb_=(t)-(NT-4); if(jb_>=0)cmask(P0,P1,jb_,qrel,hi);}while(0)
  bool resc=false;
  #define START(P0,P1) do{ const float rm=rowmax(P0,P1); resc=false; \
    { const float dl=rm; mhat=fadd_s(mhat,dl); \
      _Pragma("unroll") for(int r=0;r<16;++r){P0[r]=fsub_s(P0[r],dl);P1[r]=fsub_s(P1[r],dl);} \
      } \
    _Pragma("unroll") for(int r=0;r<16;++r)P0[r]=__builtin_amdgcn_exp2f(P0[r]); }while(0)
  #define RESC() do{ if(resc){ asm volatile("s_waitcnt lgkmcnt(0)":::"memory"); \
      _Pragma("unroll") for(int d_=0;d_<2;++d_) _Pragma("unroll") for(int r=0;r<16;++r)o[d_][r]*=wsf[crow(r,hi)]; } }while(0)
  f32x16 pA0,pA1,pB0,pB1;
  int sl_prev=0,sl_cur=0,sl_next=SLOTB;
  #define ROT() do{sl_prev=sl_cur;sl_cur=sl_next;sl_next=(sl_next==(NSLOT-1)*SLOTB)?0:sl_next+SLOTB;}while(0)
  DMA_K(2,2*SLOTB);
  WAIT_BAR(3);
  CINIT(pA0,pA1,0);
  qkt(pA0,pA1,Kbase,qr,r32,hi);asm volatile("s_nop 15\n\ts_nop 7":"+v"(pA0),"+v"(pA1));CMASK(pA0,pA1,0);
  START(pA0,pA1);
  _Pragma("unroll") for(int r=0;r<16;++r)pA1[r]=__builtin_amdgcn_exp2f(pA1[r]);
  WAIT_BAR(0);
  DMA_K(3,0);DMA_V(1,SLOTB);
  ROT();
  kload8(kf,kp0+sl_cur);
  WAIT_BAR(2);
  s16x4 vlo[8],vhi[8]; u32x4 pw0,pw1,pw2,pw3;
  #define PKW(P,B) cvtpk_s(P[B],P[B+1])
  #define PAF(k) __builtin_bit_cast(bf16x8,pw##k)
  #define VFR(i) (bf16x8){vlo[i][0],vlo[i][1],vlo[i][2],vlo[i][3],vhi[i][0],vhi[i][1],vhi[i][2],vhi[i][3]}
  #define PIN(x) asm volatile("":"+v"(x))
  #define MX3(a,b,c) __builtin_fmaxf(__builtin_fmaxf((a),(b)),(c))
  #define GAPA(MF,A0,A1,A2,A3,W0,W1,PW) do{ MF; sacc+=A0; sacc+=A1; sacc+=A2; sacc+=A3; PIN(sacc); W0; W1; PIN(PW); SBAR(); }while(0)
  #define EX(v) __builtin_amdgcn_exp2f(v)
  #define GAPB(MF,X,B) do{ MF; X[B]=EX(X[B]); X[B+1]=EX(X[B+1]); X[B+2]=EX(X[B+2]); X[B+3]=EX(X[B+3]); PIN(X); SBAR(); }while(0)
  #define VRD(i) do{ vlo[i]=vtr(vp_+(((i)>>2)*4096+((i)&3)*1024)); vhi[i]=vtr(vp_+(((i)>>2)*4096+((i)&3)*1024+512)); }while(0)
  #define KRD(G,j) do{ if(G){ kload2(kf,kp0+sl_next,j); SBAR(); } }while(0)
  #define STEP(C0,C1,P0,P1,t,GK,GV,GL) do{ SBAR(); CINIT(C0,C1,t); SBAR(); \
    const lds_cptr vp_=vp0+sl_prev; \
    VRD(0); SBAR(); float sacc=(P0[0]+P0[1]); \
    GAPA(C0=__builtin_amdgcn_mfma_f32_32x32x16_bf16(kf[0],qr[0],C0,0,0,0), P0[2],P0[3],P0[4],P0[5],     pw0[0]=PKW(P0,0), pw0[1]=PKW(P0,2), pw0); \
    VRD(4); SBAR(); GAPA(C1=__builtin_amdgcn_mfma_f32_32x32x16_bf16(kf[1],qr[0],C1,0,0,0), P0[6],P0[7],P0[8],P0[9],     pw0[2]=PKW(P0,4), pw0[3]=PKW(P0,6), pw0); \
    VRD(1); SBAR(); GAPA(C0=__builtin_amdgcn_mfma_f32_32x32x16_bf16(kf[2],qr[1],C0,0,0,0),   P0[10],P0[11],P0[12],P0[13], pw1[0]=PKW(P0,8), pw1[1]=PKW(P0,10), pw1); \
    VRD(5); SBAR(); GAPA(C1=__builtin_amdgcn_mfma_f32_32x32x16_bf16(kf[3],qr[1],C1,0,0,0),   P0[14],P0[15],P1[0],P1[1],   pw1[2]=PKW(P0,12),pw1[3]=PKW(P0,14), pw1); \
    VRD(2); SBAR(); GAPA(C0=__builtin_amdgcn_mfma_f32_32x32x16_bf16(kf[4],qr[2],C0,0,0,0),   P1[2],P1[3],P1[4],P1[5],     pw2[0]=PKW(P1,0), pw2[1]=PKW(P1,2), pw2); \
    VRD(6); SBAR(); GAPA(C1=__builtin_amdgcn_mfma_f32_32x32x16_bf16(kf[5],qr[2],C1,0,0,0),   P1[6],P1[7],P1[8],P1[9],     pw2[2]=PKW(P1,4), pw2[3]=PKW(P1,6), pw2); \
    VRD(3); SBAR(); GAPA(C0=__builtin_amdgcn_mfma_f32_32x32x16_bf16(kf[6],qr[3],C0,0,0,0),   P1[10],P1[11],P1[12],P1[13], pw3[0]=PKW(P1,8), pw3[1]=PKW(P1,10), pw3); \
    VRD(7); SBAR(); GAPA(C1=__builtin_amdgcn_mfma_f32_32x32x16_bf16(kf[7],qr[3],C1,0,0,0),   P1[14],P1[15],0.f,0.f,       pw3[2]=PKW(P1,12),pw3[3]=PKW(P1,14), pw3); \
    l_reg+=sacc; \
    if(GK){DMA_K((t)+3,sl_cur);} if(GV){DMA_V((t)+1,sl_next);} \
    CMASK(C0,C1,t); \
    { float a=MX3(C0[0],C0[1],C1[0]),b=MX3(C0[2],C0[3],C1[1]); a=MX3(a,C1[2],C1[3]); \
      _Pragma("unroll") for(int r=4;r<16;r+=4){a=MX3(a,C0[r],C0[r+1]);b=MX3(b,C0[r+2],C0[r+3]);a=MX3(a,C1[r],C1[r+1]);b=MX3(b,C1[r+2],C1[r+3]);} \
      float rm=__builtin_fmaxf(a,b); { auto rr=__builtin_amdgcn_permlane32_swap(__float_as_uint(rm),__float_as_uint(rm),false,false); rm=__builtin_fmaxf(__uint_as_float(rr[0]),__uint_as_float(rr[1])); } \
      resc=false; \
      if(__builtin_expect(__any(rm>(float)THRL),0)){ const float dl=__builtin_fmaxf(rm,0.f); mhat+=dl; \
        _Pragma("unroll") for(int r=0;r<16;++r){C0[r]-=dl;C1[r]-=dl;} \
        const float f=__builtin_amdgcn_exp2f(-dl); l_reg*=f; if(hi==0)wsf[r32]=f; resc=true; } } \
    SBAR(); \
    GAPB(o[0]=__builtin_amdgcn_mfma_f32_32x32x16_bf16(PAF(0),VFR(0),o[0],0,0,0), C0,0); \
    GAPB(o[1]=__builtin_amdgcn_mfma_f32_32x32x16_bf16(PAF(0),VFR(4),o[1],0,0,0), C0,4); \
    KRD(GL,0); GAPB(o[0]=__builtin_amdgcn_mfma_f32_32x32x16_bf16(PAF(1),VFR(1),o[0],0,0,0), C0,8); \
    KRD(GL,1); GAPB(o[1]=__builtin_amdgcn_mfma_f32_32x32x16_bf16(PAF(1),VFR(5),o[1],0,0,0), C0,12); \
    KRD(GL,2); GAPB(o[0]=__builtin_amdgcn_mfma_f32_32x32x16_bf16(PAF(2),VFR(2),o[0],0,0,0), C1,0); \
    KRD(GL,3); GAPB(o[1]=__builtin_amdgcn_mfma_f32_32x32x16_bf16(PAF(2),VFR(6),o[1],0,0,0), C1,4); \
    GAPB(o[0]=__builtin_amdgcn_mfma_f32_32x32x16_bf16(PAF(3),VFR(3),o[0],0,0,0), C1,8); \
    GAPB(o[1]=__builtin_amdgcn_mfma_f32_32x32x16_bf16(PAF(3),VFR(7),o[1],0,0,0), C1,12); \
    }while(0)
  int t=1;
  #undef CMASK
  #define CMASK(P0,P1,t) do{}while(0)
  for(;t+5<NT;t+=2){
    STEP(pB0,pB1,pA0,pA1,t,true,true,true);     WAIT_BAR(2); RESC(); ROT();
    STEP(pA0,pA1,pB0,pB1,t+1,true,true,true);   WAIT_BAR(2); RESC(); ROT();
  }
  #undef CMASK
  #define CMASK(P0,P1,t) do{int jb_=(t)-(NT-4); if(jb_>=0)cmask(P0,P1,jb_,qrel,hi);}while(0)
  #define ENDW(tt) do{ if((tt)+3<NT){WAIT_BAR(2);} else if((tt)+2<NT){WAIT_BAR(1);} else {WAIT_BAR(0);} }while(0)
  for(;t+1<NT;t+=2){
    STEP(pB0,pB1,pA0,pA1,t,(t+3<NT),(t+1<NT),(t+1<NT));       ENDW(t);   RESC(); ROT();
    STEP(pA0,pA1,pB0,pB1,t+1,(t+4<NT),(t+2<NT),(t+2<NT));     ENDW(t+1); RESC(); ROT();
  }
  STEP(pB0,pB1,pA0,pA1,NT-1,false,false,false); RESC();
  { float sacc=pB0[0]+pB0[1]; _Pragma("unroll") for(int r=2;r<16;++r)sacc+=pB0[r]; _Pragma("unroll") for(int r=0;r<16;++r)sacc+=pB1[r]; l_reg+=sacc;
    pw0=(u32x4){PKW(pB0,0),PKW(pB0,2),PKW(pB0,4),PKW(pB0,6)};pw1=(u32x4){PKW(pB0,8),PKW(pB0,10),PKW(pB0,12),PKW(pB0,14)};pw2=(u32x4){PKW(pB1,0),PKW(pB1,2),PKW(pB1,4),PKW(pB1,6)};pw3=(u32x4){PKW(pB1,8),PKW(pB1,10),PKW(pB1,12),PKW(pB1,14)};
    SBAR(); pv(o,vb0+sl_cur,PAF(0),PAF(1),PAF(2),PAF(3)); }
  #undef PKW
  #undef PAF
  #undef VFR
  #undef PIN
  #undef MX3
  #undef GAPA
  #undef GAPB
  #undef EX
  #undef VRD
  #undef KRD
  #undef STEP
  #undef ENDW
  {auto rr=__builtin_amdgcn_permlane32_swap(__float_as_uint(l_reg),__float_as_uint(l_reg),false,false);l_reg=__uint_as_float(rr[0])+__uint_as_float(rr[1]);}
  if(hi==0)wsf[32+r32]=l_reg;asm volatile("s_waitcnt lgkmcnt(0)":::"memory");
  float rli[16];
  #pragma unroll
  for(int r=0;r<16;++r)rli[r]=__builtin_amdgcn_rcpf(wsf[32+crow(r,hi)]);
  bf16*Ow=O+(rowbase+q0+wid*QBLK)*DM+h*D;
  { bf16*stg=(bf16*)(shm+LDS_OST)+wid*2048;
    #pragma unroll
    for(int r=0;r<16;++r){const int orow=crow(r,hi);
      #pragma unroll
      for(int d0=0;d0<2;++d0)stg[orow*64+d0*32+r32]=__float2bfloat16(o[d0][r]*rli[r]);}
    asm volatile("s_waitcnt lgkmcnt(0)":::"memory");
    const bf16*Gw=GT+(rowbase+q0+wid*QBLK)*DM+h*D;
    u32x4 gv[4];
    #pragma unroll
    for(int i=0;i<4;++i){const int row=i*8+(lane>>3),ch=lane&7; gv[i]=*(const u32x4*)(Gw+(long)row*DM+ch*8);}
    #pragma unroll
    for(int i=0;i<4;++i){const int row=i*8+(lane>>3),ch=lane&7; u32x4 v=*(const u32x4*)(stg+row*64+ch*8);
      #pragma unroll
      for(int e=0;e<4;++e){ const float o0=__uint_as_float(v[e]<<16)*__uint_as_float(gv[i][e]<<16), o1=__uint_as_float(v[e]&0xffff0000u)*__uint_as_float(gv[i][e]&0xffff0000u); v[e]=cvtpk_s(o0,o1); }
      ATTN_STORE16(Ow+(long)row*DM+ch*8,v);} }
  asm volatile("s_waitcnt lgkmcnt(0)\n\ts_barrier":::"memory");
  #undef CINIT
  #undef DMA_K
  #undef DMA_V
  #undef CMASK
  #undef START
  #undef RESC
  #undef ROT
}
constexpr int ATTN_LDS_BYTES=LDS_BYTES;
struct AttnTensors { const bf16* Q; const bf16* K; const bf16* V; bf16* O; const bf16* G; const float* C2; };
struct AttnUnit { int bh; int qb; };
struct StaticOrder {
  int vcu, G;
  __device__ __forceinline__ explicit StaticOrder(int grid,int block):vcu((grid%8==0)?(block%8)*(grid/8)+block/8:block),G(grid){}
  __device__ __forceinline__ bool next(int i,AttnUnit&u)const{ const int bh=vcu+(i>>3)*G; if(bh>=BATCH*NHEAD)return false; u.bh=bh; u.qb=7-(i&7); return true; }
  __device__ __forceinline__ void a_ready(const AttnUnit&)const{}
  __device__ __forceinline__ void done(const AttnUnit&)const{}
};
template<class Sched,int THRL=8> __device__ __forceinline__ void attn_phase(char*lds,const AttnTensors&T,const Sched&S,const int tid){
  AttnUnit u;
  for(int i=0;S.next(i,u);++i){ S.a_ready(u); attn_unit<THRL>(u.bh/NHEAD,u.bh%NHEAD,u.qb,T.Q,T.K,T.V,T.O,T.G,T.C2,(i&7)==0,lds,tid); S.done(u); }
}
#undef SBAR
#undef WAIT_BAR
}
constexpr int NWAVES = 8;
constexpr int BATCH = 16, SEQ = 2048, D = 1024, NH = 16, FF = 2816, FF2 = 2 * FF;
constexpr int M = BATCH * SEQ;
constexpr int NKV = 2304;
constexpr float RMS_EPS = 1e-6f;
static_assert(attn_body::BATCH == BATCH && attn_body::SEQ == SEQ && attn_body::DM == D, "attention body geometry");
constexpr size_t MiB = 1u << 20;
constexpr size_t WS_WFI = 2 * MiB;
constexpr size_t WS_WFO = 46 * MiB;
constexpr size_t WS_WCI = 68 * MiB;
constexpr size_t WS_WCO = 74 * MiB;
constexpr size_t WS_WKV = 76 * MiB;
constexpr size_t WS_WQG = 81 * MiB;
constexpr size_t WS_WO = 85 * MiB;
constexpr size_t WS_FL = 88 * MiB;
constexpr size_t WS_C2 = 90 * MiB;
constexpr size_t WS_RS = 92 * MiB;
constexpr size_t WS_XH = 96 * MiB;
constexpr size_t WS_R = 160 * MiB;
constexpr size_t WS_K = 352 * MiB, WS_V = 416 * MiB, WS_END = 480 * MiB;
static_assert(WS_WFI + 4 * (size_t)FF2 * D * 2 <= WS_WFO && WS_WFO + 4 * (size_t)D * FF * 2 <= WS_WCI && WS_WKV + (size_t)NKV * D * 2 <= WS_WQG && WS_R + (size_t)M * FF * 2 <= WS_K, "d_ws map");
constexpr int RING_BYTES = 131072, LDS_BYTES = 147456;
static_assert(attn_body::ATTN_LDS_BYTES <= RING_BYTES && pg8::STAGE_BYTES <= RING_BYTES, "LDS map");

#define GAS __attribute__((address_space(1)))
#define LAS __attribute__((address_space(3)))
typedef unsigned short bf16;
typedef unsigned v4u __attribute__((ext_vector_type(4)));
typedef unsigned v2u __attribute__((ext_vector_type(2)));
typedef float f32x4 __attribute__((ext_vector_type(4)));
#define LDS_WAIT() asm volatile("s_waitcnt lgkmcnt(0)" ::: "memory")
__device__ __forceinline__ unsigned f2bf(float f) { unsigned u = __builtin_bit_cast(unsigned, f); return (u + 0x7fffu + ((u >> 16) & 1u)) >> 16; }
__device__ __forceinline__ unsigned pk2(float lo, float hi) { return f2bf(lo) | (f2bf(hi) << 16); }
__device__ __forceinline__ float bflo(unsigned w) { return __uint_as_float(w << 16); }
__device__ __forceinline__ float bfhi(unsigned w) { return __uint_as_float(w & 0xffff0000u); }

struct Frame { LAS unsigned char* lds; int tid, lane, wave, vcu, G; };

__device__ __forceinline__ float wave_sum(float v) {
#pragma unroll
    for (int o = 1; o < 64; o <<= 1) v += __shfl_xor(v, o);
    return v;
}
enum { MAP_PLAIN = 0, MAP_SWIGLU = 1, MAP_CONV = 2 };
__device__ __forceinline__ int map_row(int mode, int n0) {
    if (mode == MAP_SWIGLU) { const int up = n0 >= FF ? 1 : 0, j = n0 - up * FF; return 256 * (j >> 7) + 128 * up + (j & 127); }
    if (mode == MAP_CONV) { if (n0 < D) return 2 * D + n0; const int hh = n0 >= 2 * D ? 1 : 0, j = n0 - D - hh * D; return 256 * (j >> 7) + 128 * hh + (j & 127); }
    return n0;
}
__device__ __forceinline__ void cvt_item(const float* W, int ldw, int K, int ncols, const float* gain, bf16* WT, int mode, LAS float* scr, int item, int lane) {
    const int nblk = ncols / 32, kb = item / nblk, nb = item % nblk, k0 = 64 * kb, n0 = 32 * nb;
#pragma unroll 8
    for (int i = 0; i < 32; ++i) { const int kk = 2 * i + (lane >> 5); scr[kk * 33 + (lane & 31)] = W[(size_t)(k0 + kk) * ldw + n0 + (lane & 31)]; }
    const int c = lane & 7, drow = map_row(mode, n0);
    f32x4 g0 = (f32x4){1.f, 1.f, 1.f, 1.f}, g1 = g0;
    if (gain) { g0 = *(const f32x4*)(gain + k0 + 8 * c); g1 = *(const f32x4*)(gain + k0 + 8 * c + 4); }
    LDS_WAIT(); asm volatile("" ::: "memory");
#pragma unroll
    for (int j = 0; j < 4; ++j) { const int n = (lane >> 3) + 8 * j; const LAS float* s = scr + (8 * c) * 33 + n;
        v4u o; o.x = pk2(s[0 * 33] * g0[0], s[1 * 33] * g0[1]); o.y = pk2(s[2 * 33] * g0[2], s[3 * 33] * g0[3]); o.z = pk2(s[4 * 33] * g1[0], s[5 * 33] * g1[1]); o.w = pk2(s[6 * 33] * g1[2], s[7 * 33] * g1[3]);
        *(GAS v4u*)(WT + (size_t)(drow + n) * K + k0 + 8 * c) = o; }
    LDS_WAIT(); asm volatile("" ::: "memory");
}
struct Ptrs {
    const float *x, *ffn1_pre_g, *ffn1_post_g, *ffn1_w_in, *ffn1_w_out, *mix_pre_g, *mix_post_g, *ffn2_pre_g, *ffn2_post_g, *ffn2_w_in, *ffn2_w_out,
                *conv_w_in, *conv_k, *conv_w_out, *kv_g, *kv_w, *forget_b, *attn_w_qg, *attn_w_o;
};
__device__ __forceinline__ void convert_weights(const Frame& F, const Ptrs& P, unsigned char* ws) {
    LAS float* scr = (LAS float*)(F.lds + F.wave * 16384);
    const int gw = F.vcu * NWAVES + F.wave, NGW = F.G * NWAVES;
    constexpr int I_FI = (D / 64) * (FF2 / 32), I_FO = (FF / 64) * (D / 32), I_CI = (D / 64) * (3 * D / 32), I_DD = (D / 64) * (D / 32), I_2D = (D / 64) * (2 * D / 32);
    constexpr int NITEMS = 4 * I_FI + 4 * I_FO + I_CI + I_DD + I_2D + I_2D + I_DD;
    for (int it = gw; it < NITEMS; it += NGW) {
        int r = it;
        if (r < 4 * I_FI) { const int i = r / I_FI, l = i >> 1, w2 = i & 1; r -= i * I_FI;
            cvt_item((w2 ? P.ffn2_w_in : P.ffn1_w_in) + (size_t)l * D * FF2, FF2, D, FF2, (w2 ? P.ffn2_pre_g : P.ffn1_pre_g) + l * D, (bf16*)(ws + WS_WFI) + (size_t)i * FF2 * D, MAP_SWIGLU, scr, r, F.lane); continue; }
        r -= 4 * I_FI;
        if (r < 4 * I_FO) { const int i = r / I_FO, l = i >> 1, w2 = i & 1; r -= i * I_FO;
            cvt_item((w2 ? P.ffn2_w_out : P.ffn1_w_out) + (size_t)l * FF * D, D, FF, D, nullptr, (bf16*)(ws + WS_WFO) + (size_t)i * D * FF, MAP_PLAIN, scr, r, F.lane); continue; }
        r -= 4 * I_FO;
        if (r < I_CI) { cvt_item(P.conv_w_in, 3 * D, D, 3 * D, P.mix_pre_g, (bf16*)(ws + WS_WCI), MAP_CONV, scr, r, F.lane); continue; } r -= I_CI;
        if (r < I_DD) { cvt_item(P.conv_w_out, D, D, D, nullptr, (bf16*)(ws + WS_WCO), MAP_PLAIN, scr, r, F.lane); continue; } r -= I_DD;
        if (r < I_2D) { cvt_item(P.kv_w, 2 * D + NH, D, 2 * D, P.kv_g, (bf16*)(ws + WS_WKV), MAP_PLAIN, scr, r, F.lane); continue; } r -= I_2D;
        if (r < I_2D) { cvt_item(P.attn_w_qg, 2 * D, D, 2 * D, P.mix_pre_g + D, (bf16*)(ws + WS_WQG), MAP_PLAIN, scr, r, F.lane); continue; } r -= I_2D;
        cvt_item(P.attn_w_o, D, D, D, nullptr, (bf16*)(ws + WS_WO), MAP_PLAIN, scr, r, F.lane);
    }
    bf16* wkv = (bf16*)(ws + WS_WKV);
    const int gt = F.vcu * (NWAVES * 64) + F.tid, NGT = F.G * NWAVES * 64;
    for (int e = gt; e < NH * D; e += NGT) { const int n = e / D, k = e % D; wkv[(size_t)(2 * D + n) * D + k] = (bf16)f2bf(P.kv_w[(size_t)k * (2 * D + NH) + 2 * D + n] * P.kv_g[k]); }
    unsigned* wz = (unsigned*)(wkv + (size_t)(2 * D + NH) * D);
    for (int e = gt; e < (NKV - 2 * D - NH) * D / 2; e += NGT) wz[e] = 0u;
}
__device__ __forceinline__ void thin_phase(const Frame& F, const float* xin, bf16* X, const bf16* hb, const float* gpost, float w, float* rs, float* outf, int flags) {
    constexpr int R = 4;
    const int gw = F.vcu * NWAVES + F.wave, NGW = F.G * NWAVES, lane = F.lane;
    const bool has_h = flags & 1, src32 = flags & 2, fin = flags & 4;
    f32x4 gp[4];
#pragma unroll
    for (int j = 0; j < 4; ++j) gp[j] = has_h ? *(const GAS f32x4*)(gpost + 4 * lane + 256 * j) * w : (f32x4){0.f, 0.f, 0.f, 0.f};
    for (long base = (long)gw * R; base < M; base += (long)NGW * R) {
        f32x4 xv[R][4]; v2u hv[R][4];
        if (src32) {
#pragma unroll
            for (int r = 0; r < R; ++r)
#pragma unroll
                for (int j = 0; j < 4; ++j) xv[r][j] = *(const GAS f32x4*)(xin + (size_t)(base + r) * D + 4 * lane + 256 * j);
        } else {
#pragma unroll
            for (int r = 0; r < R; ++r)
#pragma unroll
                for (int j = 0; j < 4; ++j) { const v2u t = *(const GAS v2u*)(X + (size_t)(base + r) * D + 4 * lane + 256 * j); xv[r][j] = (f32x4){bflo(t.x), bfhi(t.x), bflo(t.y), bfhi(t.y)}; }
        }
        if (has_h) {
#pragma unroll
            for (int r = 0; r < R; ++r)
#pragma unroll
                for (int j = 0; j < 4; ++j) hv[r][j] = *(const GAS v2u*)(hb + (size_t)(base + r) * D + 4 * lane + 256 * j);
        }
#pragma unroll
        for (int r = 0; r < R; ++r) {
            if (has_h) {
                f32x4 h[4]; float ss = 0.f;
#pragma unroll
                for (int j = 0; j < 4; ++j) { h[j] = (f32x4){bflo(hv[r][j].x), bfhi(hv[r][j].x), bflo(hv[r][j].y), bfhi(hv[r][j].y)}; ss += (h[j].x * h[j].x + h[j].y * h[j].y) + (h[j].z * h[j].z + h[j].w * h[j].w); }
                const float rh = 1.0f / sqrtf(wave_sum(ss) * (1.0f / D) + RMS_EPS);
#pragma unroll
                for (int j = 0; j < 4; ++j) xv[r][j] += h[j] * rh * gp[j];
            }
            if (fin) {
#pragma unroll
                for (int j = 0; j < 4; ++j) *(GAS f32x4*)(outf + (size_t)(base + r) * D + 4 * lane + 256 * j) = xv[r][j];
            } else {
                float s2 = 0.f;
#pragma unroll
                for (int j = 0; j < 4; ++j) s2 += (xv[r][j].x * xv[r][j].x + xv[r][j].y * xv[r][j].y) + (xv[r][j].z * xv[r][j].z + xv[r][j].w * xv[r][j].w);
                const float r2 = 1.0f / sqrtf(wave_sum(s2) * (1.0f / D) + RMS_EPS);
                if (lane == 0) rs[base + r] = r2;
#pragma unroll
                for (int j = 0; j < 4; ++j) { v2u o; o.x = pk2(xv[r][j].x, xv[r][j].y); o.y = pk2(xv[r][j].z, xv[r][j].w); *(GAS v2u*)(X + (size_t)(base + r) * D + 4 * lane + 256 * j) = o; }
            }
        }
    }
}
__device__ __forceinline__ void conv_phase(const Frame& F, const bf16* U, const bf16* Bg, const float* ck, bf16* Z) {
    constexpr int RB = 16;
    const int gw = F.vcu * NWAVES + F.wave, NGW = F.G * NWAVES, lane = F.lane;
    for (int it = gw; it < (M / RB) * 2; it += NGW) {
        const int r0 = (it >> 1) * RB, c0 = (it & 1) * 512 + lane * 8;
        float kw[3][8];
#pragma unroll
        for (int wq = 0; wq < 3; ++wq) { const f32x4 a = *(const f32x4*)(ck + wq * D + c0), b = *(const f32x4*)(ck + wq * D + c0 + 4);
            kw[wq][0] = a.x; kw[wq][1] = a.y; kw[wq][2] = a.z; kw[wq][3] = a.w; kw[wq][4] = b.x; kw[wq][5] = b.y; kw[wq][6] = b.z; kw[wq][7] = b.w; }
        const bool first = (r0 % SEQ) == 0;
        v4u u2 = (v4u){0u, 0u, 0u, 0u}, u1 = u2;
        if (!first) { u2 = *(const GAS v4u*)(U + (size_t)(r0 - 2) * D + c0); u1 = *(const GAS v4u*)(U + (size_t)(r0 - 1) * D + c0); }
#pragma unroll 4
        for (int r = 0; r < RB; ++r) {
            const v4u u0 = *(const GAS v4u*)(U + (size_t)(r0 + r) * D + c0), bg = *(const GAS v4u*)(Bg + (size_t)(r0 + r) * D + c0);
            v4u o;
#pragma unroll
            for (int e = 0; e < 4; ++e) {
                const float ylo = kw[0][2 * e] * bflo(u2[e]) + kw[1][2 * e] * bflo(u1[e]) + kw[2][2 * e] * bflo(u0[e]);
                const float yhi = kw[0][2 * e + 1] * bfhi(u2[e]) + kw[1][2 * e + 1] * bfhi(u1[e]) + kw[2][2 * e + 1] * bfhi(u0[e]);
                o[e] = pk2(ylo * bflo(bg[e]), yhi * bfhi(bg[e]));
            }
            *(GAS v4u*)(Z + (size_t)(r0 + r) * D + c0) = o;
            u2 = u1; u1 = u0;
        }
    }
}
__device__ __forceinline__ void cumsum_phase(const Frame& F, const float* FL, const float* fb, float* C2) {
    if (F.wave != 0) return;
    for (int bh = F.vcu; bh < BATCH * NH; bh += F.G) {
        const int b = bh / NH, h = bh % NH; const float bias = fb[h]; float carry = 0.f;
        for (int j = 0; j < SEQ / 64; ++j) {
            const int t = 64 * j + F.lane; const float xl = FL[((size_t)b * SEQ + t) * NH + h] + bias;
            float v = fminf(xl, 0.f) - log1pf(expf(-fabsf(xl)));
#pragma unroll
            for (int o = 1; o < 64; o <<= 1) { const float y = __shfl_up(v, o); if (F.lane >= o) v += y; }
            v += carry; C2[(size_t)bh * SEQ + t] = v * 1.4426950408889634f; carry = __shfl(v, 63);
        }
    }
}

struct Args { const float* in[19]; float* out; unsigned char* ws; };
__global__ void __launch_bounds__(NWAVES * 64, 2) yoco_fwd(Args args) {
    extern __shared__ __attribute__((aligned(16))) unsigned char lds[];
    cg::grid_group grid = cg::this_grid();
    Frame F;
    F.lds = (LAS unsigned char*)lds; F.tid = threadIdx.x; F.lane = F.tid & 63; F.wave = __builtin_amdgcn_readfirstlane(F.tid >> 6);
    F.G = gridDim.x; { const int bx = blockIdx.x; F.vcu = (F.G % 8 == 0) ? (bx % 8) * (F.G / 8) + bx / 8 : bx; }
    Ptrs P;
    P.x = args.in[0]; P.ffn1_pre_g = args.in[1]; P.ffn1_post_g = args.in[2]; P.ffn1_w_in = args.in[3]; P.ffn1_w_out = args.in[4]; P.mix_pre_g = args.in[5]; P.mix_post_g = args.in[6];
    P.ffn2_pre_g = args.in[7]; P.ffn2_post_g = args.in[8]; P.ffn2_w_in = args.in[9]; P.ffn2_w_out = args.in[10]; P.conv_w_in = args.in[11]; P.conv_k = args.in[12]; P.conv_w_out = args.in[13];
    P.kv_g = args.in[14]; P.kv_w = args.in[15]; P.forget_b = args.in[16]; P.attn_w_qg = args.in[17]; P.attn_w_o = args.in[18];
    float* out = args.out; unsigned char* ws = args.ws;
    bf16* const XH = (bf16*)(ws + WS_XH); bf16* const RH = (bf16*)(ws + WS_R);
    bf16* const Ub = RH; bf16* const Bgb = RH + (size_t)M * D; bf16* const Zb = RH + 2 * (size_t)M * D;
    bf16* const Qb = RH; bf16* const Gtb = RH + (size_t)M * D;
    bf16* const Kb = (bf16*)(ws + WS_K); bf16* const Vb = (bf16*)(ws + WS_V);
    bf16* const WFI = (bf16*)(ws + WS_WFI); bf16* const WFO = (bf16*)(ws + WS_WFO);
    float* const FL = (float*)(ws + WS_FL); float* const C2 = (float*)(ws + WS_C2); float* const RS = (float*)(ws + WS_RS);
    bf16* const HS = (bf16*)out;

    enum { K_GEMM = 0, K_THIN = 1, K_CONV = 2, K_ATT = 3 };
    constexpr int NPH = 21;
    struct PhaseDesc { unsigned long long p0, p1, p2, p3; int kind, mode, N, K, ldc, flags; float w; int sync; };
    LAS unsigned* const tabw = (LAS unsigned*)(F.lds + RING_BYTES + 1024);
#define TAB_PUT(i, d) do { LAS unsigned* t_ = tabw + 16 * (i); t_[0] = (unsigned)(d).p0; t_[1] = (unsigned)((d).p0 >> 32); t_[2] = (unsigned)(d).p1; t_[3] = (unsigned)((d).p1 >> 32); t_[4] = (unsigned)(d).p2; t_[5] = (unsigned)((d).p2 >> 32); \
        t_[6] = (unsigned)(d).p3; t_[7] = (unsigned)((d).p3 >> 32); t_[8] = (unsigned)(d).kind; t_[9] = (unsigned)(d).mode; t_[10] = (unsigned)(d).N; t_[11] = (unsigned)(d).K; t_[12] = (unsigned)(d).ldc; t_[13] = (unsigned)(d).flags; \
        t_[14] = __float_as_uint((d).w); t_[15] = (unsigned)(d).sync; } while (0)
    if (F.tid == 0) {
#define PD_GEMM(i, A_, B_, N_, K_, mode_, O0_, O1_, ldc_, sync_) do { PhaseDesc d; d.p0 = (unsigned long long)(A_); d.p1 = (unsigned long long)(B_); d.p2 = (unsigned long long)(O0_); d.p3 = (unsigned long long)(O1_); \
        d.kind = K_GEMM; d.mode = (mode_); d.N = (N_); d.K = (K_); d.ldc = (ldc_); d.flags = 0; d.w = 0.f; d.sync = (sync_); TAB_PUT(i, d); } while (0)
#define PD_THIN(i, hs_, g_, w_, flags_, cums_, sync_) do { PhaseDesc d; d.p0 = (unsigned long long)(hs_); d.p1 = (unsigned long long)(g_); d.p2 = 0; d.p3 = 0; \
        d.kind = K_THIN; d.mode = (cums_); d.N = 0; d.K = 0; d.ldc = 0; d.flags = (flags_); d.w = (w_); d.sync = (sync_); TAB_PUT(i, d); } while (0)
#define PD_OTHER(i, kind_) do { PhaseDesc d; d.p0 = 0; d.p1 = 0; d.p2 = 0; d.p3 = 0; d.kind = (kind_); d.mode = 0; d.N = 0; d.K = 0; d.ldc = 0; d.flags = 0; d.w = 0.f; d.sync = 1; TAB_PUT(i, d); } while (0)
#define PD_UP(i, j)   PD_GEMM(i, XH, WFI + (size_t)(j) * FF2 * D, FF2, D, pg8::EM_SWIGLU, RH, 0, FF, 1)
#define PD_DOWN(i, j, hs) PD_GEMM(i, RH, WFO + (size_t)(j) * D * FF, D, FF, pg8::EM_PLAIN, hs, 0, D, 1)
        PD_UP(0, 0); PD_DOWN(1, 0, HS);
        PD_THIN(2, HS, P.ffn1_post_g, 0.5f, 1, 0, 1);
        PD_GEMM(3, XH, ws + WS_WCI, 3 * D, D, pg8::EM_CONV, Ub, Bgb, D, 1);
        PD_OTHER(4, K_CONV);
        PD_GEMM(5, Zb, ws + WS_WCO, D, D, pg8::EM_PLAIN, HS, 0, D, 1);
        PD_THIN(6, HS, P.mix_post_g, 1.0f, 1, 0, 1);
        PD_UP(7, 1); PD_DOWN(8, 1, HS);
        PD_THIN(9, HS, P.ffn2_post_g, 0.5f, 1, 0, 1);
        PD_GEMM(10, XH, ws + WS_WKV, NKV, D, pg8::EM_KV, Kb, Vb, D, 0);
        PD_UP(11, 2); PD_DOWN(12, 2, HS);
        PD_THIN(13, HS, P.ffn1_post_g + D, 0.5f, 1, 1, 1);
        PD_GEMM(14, XH, ws + WS_WQG, 2 * D, D, pg8::EM_QG, Qb, Gtb, D, 1);
        PD_OTHER(15, K_ATT);
        PD_GEMM(16, Qb, ws + WS_WO, D, D, pg8::EM_PLAIN, HS, 0, D, 1);
        PD_THIN(17, HS, P.mix_post_g + D, 1.0f, 1, 0, 1);
        PD_UP(18, 3); PD_DOWN(19, 3, Kb);
        PD_THIN(20, Kb, P.ffn2_post_g + D, 0.5f, 5, 0, 0);
#undef PD_GEMM
#undef PD_THIN
#undef PD_OTHER
#undef PD_UP
#undef PD_DOWN
    }
    convert_weights(F, P, ws);
    thin_phase(F, P.x, XH, nullptr, nullptr, 0.f, RS, nullptr, 2);
    const float* const conv_k = P.conv_k; const float* const forget_b = P.forget_b;
    grid.sync();
#define RFL(v) __builtin_amdgcn_readfirstlane((int)(v))
#define RFL64(v) (((unsigned long long)(unsigned)RFL((v) >> 32) << 32) | (unsigned long long)(unsigned)RFL((v) & 0xffffffffull))
    const int wave0 = F.wave, bx0 = (int)blockIdx.x, vcu0 = F.vcu;
    for (int ph = 0; ph < NPH; ++ph) {
        int tid, bx = bx0, vcu = vcu0; asm volatile("v_mbcnt_lo_u32_b32 %0, -1, 0\n\tv_mbcnt_hi_u32_b32 %0, -1, %0" : "=v"(tid)); asm volatile("" : "+s"(bx), "+s"(vcu));
        tid += wave0 * 64;
        F.tid = tid; F.lane = tid & 63; F.wave = __builtin_amdgcn_readfirstlane(tid >> 6); F.vcu = vcu;
        const LAS unsigned* const td = tabw + 16 * ph;
#define TD32(k) RFL(td[k])
#define TD64(k) (((unsigned long long)(unsigned)TD32((k) + 1) << 32) | (unsigned long long)(unsigned)TD32(k))
        const int kind = TD32(8);
        if (kind == K_GEMM) {
            pg8::Gemm g{(const bf16*)TD64(0), (const bf16*)TD64(2), M, TD32(10), TD32(11)};
            pg8::EpiMulti E{TD32(9), (pg8::EpiMulti::gbf)TD64(4), (pg8::EpiMulti::gbf)TD64(6), (pg8::EpiMulti::gf32)FL, TD32(12), attn_body::C2, (const GAS float*)RS};
            pg8::StaticOrder S; S.init(g.M, g.N, F.G, bx);
            pg8::gemm_phase<pg8::EpiMulti, pg8::StaticOrder, true, true>(F.lds, g, S, E, tid);
        } else if (kind == K_THIN) {
            if (TD32(9)) cumsum_phase(F, FL, forget_b, C2);
            thin_phase(F, nullptr, XH, (const bf16*)TD64(0), (const float*)TD64(2), __uint_as_float((unsigned)TD32(14)), RS, out, TD32(13));
        } else if (kind == K_CONV) {
            conv_phase(F, Ub, Bgb, conv_k, Zb);
        } else {
            const attn_body::AttnTensors AT{(const attn_body::bf16*)Qb, (const attn_body::bf16*)Kb, (const attn_body::bf16*)Vb, (attn_body::bf16*)Qb, (const attn_body::bf16*)Gtb, C2};
            const attn_body::StaticOrder S((int)F.G, bx);
            attn_body::attn_phase<attn_body::StaticOrder>((char*)lds, AT, S, tid);
        }
        asm volatile("" ::: "memory");
        if (TD32(15)) grid.sync();
    }
#undef TD32
#undef TD64
#undef RFL
#undef RFL64
}

extern "C" void kernel_launch(void* const* d_in, const int* in_sizes, int n_in, void* d_out, int out_size, void* d_ws, size_t ws_size, hipStream_t stream) {
    static int grid = 0;
    if (grid == 0) {
        if (n_in != 19 || in_sizes[0] != M * D || out_size != M * D || ws_size < WS_END) { fprintf(stderr, "kernel_launch: unexpected shapes (n_in %d, in0 %d, out %d, ws %zu); nothing launched\n", n_in, n_in > 0 ? in_sizes[0] : -1, out_size, ws_size); grid = -1; return; }
        int dev = 0, cus = 0, per_cu = 0;
        if (hipGetDevice(&dev) != hipSuccess || hipDeviceGetAttribute(&cus, hipDeviceAttributeMultiprocessorCount, dev) != hipSuccess) { fprintf(stderr, "kernel_launch: device query failed\n"); grid = -1; return; }
        if (hipFuncSetAttribute((const void*)yoco_fwd, hipFuncAttributeMaxDynamicSharedMemorySize, LDS_BYTES) != hipSuccess) { fprintf(stderr, "kernel_launch: hipFuncSetAttribute failed\n"); grid = -1; return; }
        if (hipOccupancyMaxActiveBlocksPerMultiprocessor(&per_cu, (const void*)yoco_fwd, NWAVES * 64, LDS_BYTES) != hipSuccess || per_cu < 1) { fprintf(stderr, "kernel_launch: occupancy query says %d blocks per CU\n", per_cu); per_cu = 1; }
        (void)hipGetLastError();
        grid = cus * per_cu;
    }
    if (grid < 0) return;
    Args a{};
    for (int i = 0; i < 19; ++i) a.in[i] = (const float*)d_in[i];
    a.out = (float*)d_out; a.ws = (unsigned char*)d_ws;
    void* kargs[] = {&a};
    const hipError_t e = hipLaunchCooperativeKernel((const void*)yoco_fwd, dim3(grid), dim3(NWAVES * 64), kargs, LDS_BYTES, stream);
    if (e != hipSuccess) fprintf(stderr, "kernel_launch: cooperative launch failed: %s (grid %d)\n", hipGetErrorString(e), grid);
}
```

```cpp
#include <hip/hip_runtime.h>
#include <hip/hip_cooperative_groups.h>
#include <cstdio>
#include <cstdint>
namespace cg = cooperative_groups;
namespace pg8 {
#define PG8_LAS __attribute__((address_space(3)))
typedef unsigned short bf16_t;
typedef short bf16x8 __attribute__((ext_vector_type(8)));
typedef float f32x4 __attribute__((ext_vector_type(4)));
typedef unsigned u32x4 __attribute__((ext_vector_type(4)));
constexpr int BM = 256, BK = 64, HALF = 128, HTB = HALF * BK * 2  , STAGE_BYTES = 8 * HTB, NXCD = 8, WGM = 8;

__host__ __device__ __forceinline__ int lds_byte(int r, int c) { const int st = (r >> 4) * 2 + (c >> 5), rr = r & 15, cc = c & 31, ob = rr * 64 + cc * 2; return st * 1024 + (ob ^ (((ob >> 9) & 1) << 5)); }
__host__ __device__ __forceinline__ void stage_rc(int b, int& R, int& C) { const int st = b / 1024, sb = b % 1024, swz = sb ^ (((sb >> 9) & 1) << 5); R = (st >> 1) * 16 + swz / 64; C = (st & 1) * 32 + (swz % 64) / 2; }
__host__ __device__ __forceinline__ int perm32(int rho) { const int n = rho >> 4, i = rho & 15; return 8 * (i >> 2) + 4 * n + (i & 3); }

struct Unit { int pm, pn; };
struct Gemm { const bf16_t* A; const bf16_t* Bt; int M, N, K; };

struct StaticOrder {
    int nM, nN, nwg, G, c;
    __host__ __device__ void init(int M, int N, int G_, int c_) { nM = M / BM; nN = N / BM; nwg = nM * nN; G = G_; c = c_; }
    __host__ __device__ bool next(int i, Unit& u) const {
        const long L = (long)i * G + c; if (L >= nwg) return false;
        int wgid = (int)L; { const int q = nwg / NXCD, r = nwg % NXCD, xcd = wgid % NXCD, off = wgid / NXCD; wgid = (xcd < r ? xcd * (q + 1) : r * (q + 1) + (xcd - r) * q) + off; }
        const int nig = WGM * nN, gid = wgid / nig, fm = gid * WGM, gsz = (nM - fm) < WGM ? (nM - fm) : WGM;
        u.pm = fm + ((wgid % nig) % gsz); u.pn = (wgid % nig) / gsz; return true;
    }
    __device__ __forceinline__ void a_ready(const Unit&) const {}
    __device__ __forceinline__ void done(const Unit&) const {}
};

__device__ __forceinline__ unsigned cvt_pk_bf16(float lo, float hi) { unsigned r; asm volatile("v_cvt_pk_bf16_f32 %0, %1, %2" : "=v"(r) : "v"(lo), "v"(hi)); return r; }
typedef float f32x2 __attribute__((ext_vector_type(2)));
template <class Epi, class Sched, bool ALIGN_EPI = false, bool SP2 = false>
__device__ __forceinline__ void gemm_phase(PG8_LAS unsigned char* lds, const Gemm g, const Sched& S, const Epi& E, const int tid) {
    const int wid = __builtin_amdgcn_readfirstlane(tid >> 6), lane = tid & 63, wr = wid >> 2, wc = wid & 3, fr = lane & 15, fq = lane >> 4;
    const int K = g.K, nt = K / BK;
    unsigned voffA[2], voffB[2];
#pragma unroll
    for (int i = 0; i < 2; ++i) { int R, C; stage_rc(tid * 16 + i * 8192, R, C); const int Rb = Epi::PERM ? ((R & ~31) + perm32(R & 31)) : R;
        voffA[i] = (unsigned)(R * K + C) * 2u; voffB[i] = (unsigned)(Rb * K + C) * 2u; }
    const size_t kstep = (size_t)(BK * 2);
    const size_t hstep = (size_t)HALF * K * 2;
    const size_t tstep = 2 * hstep;
    const unsigned ldsw = (unsigned)wid * 1024u;
    const int aoff = lds_byte(wr * 64 + fr, fq * 8), boff = lds_byte(wc * 32 + fr, fq * 8);
#define PG8_SA(b, h) (((b) * 2 + (h)) * HTB)
#define PG8_SB(b, h) ((4 + (b) * 2 + (h)) * HTB)
#define PG8_STAGE(bufoff, gbase, voff) do { _Pragma("unroll") for (int _i = 0; _i < 2; ++_i) \
        __builtin_amdgcn_global_load_lds((const unsigned*)((const char*)(gbase) + (voff)[_i]), (PG8_LAS unsigned*)(lds + (bufoff) + ldsw + _i * 8192), 16, 0, 0); } while (0)
#define PG8_LDA(dst, b, h) do { _Pragma("unroll") for (int m = 0; m < 4; ++m) _Pragma("unroll") for (int k = 0; k < 2; ++k) dst[m][k] = *(const PG8_LAS bf16x8*)(lds + PG8_SA(b, h) + aoff + m * 2048 + k * 1024); } while (0)
#define PG8_LDB(dst, b, h) do { _Pragma("unroll") for (int n = 0; n < 2; ++n) _Pragma("unroll") for (int k = 0; k < 2; ++k) dst[n][k] = *(const PG8_LAS bf16x8*)(lds + PG8_SB(b, h) + boff + n * 2048 + k * 1024); } while (0)
#define PG8_MMA(ai, bj, At, Bt) do { __builtin_amdgcn_s_setprio(1); _Pragma("unroll") for (int m = 0; m < 4; ++m) _Pragma("unroll") for (int n = 0; n < 2; ++n) _Pragma("unroll") for (int k = 0; k < 2; ++k) \
        acc[ai][bj][m][n] = __builtin_amdgcn_mfma_f32_16x16x32_bf16(Bt[n][k], At[m][k], acc[ai][bj][m][n], 0, 0, 0); __builtin_amdgcn_s_setprio(0); } while (0)
#define PG8_WAIT_V(n) asm volatile("s_waitcnt vmcnt(" #n ")" ::: "memory")
#define PG8_WAIT_L(n) asm volatile("s_waitcnt lgkmcnt(" #n ")" ::: "memory")
#define PG8_BAR __builtin_amdgcn_s_barrier()
#define PG8_SCHED __builtin_amdgcn_sched_barrier(0)
    Unit cur, nxt; int ui = 0;
    if (!S.next(0, cur)) return;
    f32x4 acc[2][2][4][2];
#pragma unroll
    for (int a = 0; a < 2; ++a)
#pragma unroll
        for (int b = 0; b < 2; ++b)
#pragma unroll
            for (int m = 0; m < 4; ++m)
#pragma unroll
                for (int n = 0; n < 2; ++n) acc[a][b][m][n] = (f32x4){0.f, 0.f, 0.f, 0.f};
    bf16x8 At[4][2], B0[2][2], B1[2][2];
    const char* cA = (const char*)g.A + (size_t)cur.pm * tstep; const char* cB = (const char*)g.Bt + (size_t)cur.pn * tstep;
    S.a_ready(cur);
    if constexpr (SP2) {
        PG8_STAGE(PG8_SB(0, 0), cB, voffB); PG8_STAGE(PG8_SB(0, 1), cB + hstep, voffB); PG8_STAGE(PG8_SA(0, 0), cA, voffA); PG8_STAGE(PG8_SA(0, 1), cA + hstep, voffA);
        if (wr == 1) PG8_BAR;
        PG8_WAIT_V(2); PG8_BAR;
        PG8_STAGE(PG8_SB(1, 0), cB + kstep, voffB); PG8_STAGE(PG8_SA(1, 0), cA + kstep, voffA); PG8_STAGE(PG8_SB(1, 1), cB + hstep + kstep, voffB);
        PG8_WAIT_V(6); PG8_BAR;
    } else {
        PG8_STAGE(PG8_SB(0, 0), cB, voffB); PG8_STAGE(PG8_SA(0, 0), cA, voffA); PG8_STAGE(PG8_SB(0, 1), cB + hstep, voffB); PG8_STAGE(PG8_SA(0, 1), cA + hstep, voffA);
        if (wr == 1) PG8_BAR;
        PG8_WAIT_V(4); PG8_BAR;
        PG8_STAGE(PG8_SB(1, 0), cB + kstep, voffB); PG8_STAGE(PG8_SA(1, 0), cA + kstep, voffA); PG8_STAGE(PG8_SB(1, 1), cB + hstep + kstep, voffB);
        PG8_WAIT_V(6); PG8_BAR;
    }
    for (;;) {
        const bool has_next = S.next(ui + 1, nxt);
        const char* nA = has_next ? (const char*)g.A + (size_t)nxt.pm * tstep : cA; const char* nB = has_next ? (const char*)g.Bt + (size_t)nxt.pn * tstep : cB;
        for (int t = 0; t < nt; t += 2) {
            const bool last = (t == nt - 2);
            const char* a1 = cA + (size_t)(t + 1) * kstep;
            const char* a2 = last ? nA : cA + (size_t)(t + 2) * kstep; const char* b2 = last ? nB : cB + (size_t)(t + 2) * kstep;
            const char* a3 = a2 + kstep; const char* b3 = b2 + kstep;
            if (last && has_next) S.a_ready(nxt);
            if constexpr (SP2) {
            PG8_LDB(B0, 0, 0); PG8_LDB(B1, 0, 1); PG8_SCHED; PG8_LDA(At, 0, 0); PG8_STAGE(PG8_SA(1, 1), a1 + hstep, voffA);
            PG8_WAIT_V(8); PG8_WAIT_L(0); PG8_BAR; PG8_MMA(0, 0, At, B0); PG8_MMA(0, 1, At, B1); PG8_BAR; PG8_SCHED;
            PG8_LDA(At, 0, 1); PG8_STAGE(PG8_SB(0, 0), b2, voffB); PG8_STAGE(PG8_SB(0, 1), b2 + hstep, voffB); PG8_STAGE(PG8_SA(0, 0), a2, voffA);
            PG8_WAIT_V(8); PG8_WAIT_L(0); PG8_BAR; PG8_MMA(1, 0, At, B0); PG8_MMA(1, 1, At, B1); PG8_BAR; PG8_SCHED;
            PG8_LDB(B0, 1, 0); PG8_LDB(B1, 1, 1); PG8_SCHED; PG8_LDA(At, 1, 0); PG8_STAGE(PG8_SA(0, 1), a2 + hstep, voffA);
            PG8_WAIT_V(8); PG8_WAIT_L(0); PG8_BAR; PG8_MMA(0, 0, At, B0); PG8_MMA(0, 1, At, B1); PG8_BAR; PG8_SCHED;
            PG8_LDA(At, 1, 1); PG8_STAGE(PG8_SB(1, 0), b3, voffB); PG8_STAGE(PG8_SB(1, 1), b3 + hstep, voffB); PG8_STAGE(PG8_SA(1, 0), a3, voffA);
            PG8_WAIT_V(8); PG8_WAIT_L(0); PG8_BAR; PG8_MMA(1, 0, At, B0); PG8_MMA(1, 1, At, B1); PG8_BAR; PG8_SCHED;
            } else {
            PG8_LDB(B0, 0, 0); PG8_SCHED; PG8_LDA(At, 0, 0); PG8_STAGE(PG8_SA(1, 1), a1 + hstep, voffA);
            PG8_WAIT_L(8); PG8_BAR; PG8_WAIT_L(0); PG8_MMA(0, 0, At, B0); PG8_BAR; PG8_SCHED;
            PG8_LDB(B1, 0, 1); PG8_STAGE(PG8_SB(0, 0), b2, voffB);
            PG8_BAR; PG8_WAIT_L(0); PG8_MMA(0, 1, At, B1); PG8_BAR;
            PG8_LDA(At, 0, 1); PG8_STAGE(PG8_SA(0, 0), a2, voffA);
            PG8_BAR; PG8_WAIT_L(0); PG8_MMA(1, 0, At, B0); PG8_BAR; PG8_SCHED;
            PG8_STAGE(PG8_SB(0, 1), b2 + hstep, voffB);
            PG8_WAIT_V(6); PG8_BAR; PG8_MMA(1, 1, At, B1); PG8_BAR;
            PG8_LDB(B0, 1, 0); PG8_SCHED; PG8_LDA(At, 1, 0); PG8_STAGE(PG8_SA(0, 1), a2 + hstep, voffA);
            PG8_WAIT_L(8); PG8_BAR; PG8_WAIT_L(0); PG8_MMA(0, 0, At, B0); PG8_BAR; PG8_SCHED;
            PG8_LDB(B1, 1, 1); PG8_STAGE(PG8_SB(1, 0), b3, voffB);
            PG8_BAR; PG8_WAIT_L(0); PG8_MMA(0, 1, At, B1); PG8_BAR;
            PG8_LDA(At, 1, 1); PG8_STAGE(PG8_SA(1, 0), a3, voffA);
            PG8_BAR; PG8_WAIT_L(0); PG8_MMA(1, 0, At, B0); PG8_BAR; PG8_SCHED;
            PG8_STAGE(PG8_SB(1, 1), b3 + hstep, voffB);
            PG8_WAIT_V(6); PG8_BAR; PG8_MMA(1, 1, At, B1); PG8_BAR;
            }
        }
        if constexpr (ALIGN_EPI) { if (wr == 0) PG8_BAR; }
        if constexpr (!Epi::AFTER_DRAIN) { E(acc, cur, wr, wc, fr, fq); S.done(cur); }
        if (!has_next) break;
#pragma unroll
        for (int a = 0; a < 2; ++a)
#pragma unroll
            for (int b = 0; b < 2; ++b)
#pragma unroll
                for (int m = 0; m < 4; ++m)
#pragma unroll
                    for (int n = 0; n < 2; ++n) acc[a][b][m][n] = (f32x4){0.f, 0.f, 0.f, 0.f};
        cur = nxt; cA = nA; cB = nB; ++ui;
        if constexpr (ALIGN_EPI) { if (wr == 1) PG8_BAR; }
    }
    PG8_WAIT_V(0);
    if constexpr (!ALIGN_EPI) { if (wr == 0) PG8_BAR; }
    PG8_BAR;
    if constexpr (Epi::AFTER_DRAIN) { E.fused(acc, cur, wr, wc, fr, fq, lds, wid, lane); S.done(cur); }
#undef PG8_SA
#undef PG8_SB
#undef PG8_STAGE
#undef PG8_LDA
#undef PG8_LDB
#undef PG8_MMA
#undef PG8_WAIT_V
#undef PG8_WAIT_L
#undef PG8_BAR
#undef PG8_SCHED
}
}
namespace pg8 {
enum { EM_PLAIN = 0, EM_SWIGLU = 1, EM_CONV = 2, EM_KV = 3, EM_QG = 4 };
struct EpiMulti {
    static constexpr bool PERM = true, AFTER_DRAIN = false;
    typedef __attribute__((address_space(1))) bf16_t* gbf; typedef __attribute__((address_space(1))) float* gf32;
    int mode; gbf O0; gbf O1; gf32 F; int ldc; float qscale; const __attribute__((address_space(1))) float* rs;
    __device__ __forceinline__ static void st8(gbf p, f32x4 v0, f32x4 v1) { u32x4 w; w.x = cvt_pk_bf16(v0[0], v0[1]); w.y = cvt_pk_bf16(v0[2], v0[3]); w.z = cvt_pk_bf16(v1[0], v1[1]); w.w = cvt_pk_bf16(v1[2], v1[3]); *(__attribute__((address_space(1))) u32x4*)p = w; }
    __device__ __forceinline__ static f32x4 sigm(f32x4 g) { f32x4 r;
#pragma unroll
        for (int i = 0; i < 4; ++i) r[i] = __builtin_amdgcn_rcpf(1.0f + __builtin_amdgcn_exp2f(g[i] * -1.4426950408889634f)); return r; }
    __device__ __forceinline__ void operator()(const f32x4 (&acc)[2][2][4][2], const Unit& u, int wr, int wc, int fr, int fq) const {
        const int row0 = u.pm * BM + wr * 64 + fr, cl = wc * 32 + 8 * fq;
        float rv[2][4];
        if (mode != EM_PLAIN) {
#pragma unroll
            for (int ai = 0; ai < 2; ++ai)
#pragma unroll
                for (int m = 0; m < 4; ++m) rv[ai][m] = rs[row0 + ai * HALF + m * 16];
        }
        if (mode == EM_PLAIN) {
#pragma unroll
            for (int ai = 0; ai < 2; ++ai)
#pragma unroll
                for (int m = 0; m < 4; ++m) { gbf rowp = O0 + (size_t)(row0 + ai * HALF + m * 16) * ldc + u.pn * BM + cl;
#pragma unroll
                    for (int bj = 0; bj < 2; ++bj) st8(rowp + bj * HALF, acc[ai][bj][m][0], acc[ai][bj][m][1]); }
        } else if (mode == EM_SWIGLU) {
#pragma unroll
            for (int ai = 0; ai < 2; ++ai)
#pragma unroll
                for (int m = 0; m < 4; ++m) { gbf rowp = O0 + (size_t)(row0 + ai * HALF + m * 16) * ldc + u.pn * HALF + cl;
                    const float r = rv[ai][m]; const f32x4 g0 = acc[ai][0][m][0] * r, g1 = acc[ai][0][m][1] * r;
                    st8(rowp, g0 * sigm(g0) * (acc[ai][1][m][0] * r), g1 * sigm(g1) * (acc[ai][1][m][1] * r)); }
        } else if (mode == EM_CONV) {
            if (u.pn < 8) {
#pragma unroll
                for (int ai = 0; ai < 2; ++ai)
#pragma unroll
                    for (int m = 0; m < 4; ++m) { gbf rowp = O0 + (size_t)(row0 + ai * HALF + m * 16) * ldc + u.pn * HALF + cl;
                        const float r2 = rv[ai][m] * rv[ai][m]; st8(rowp, acc[ai][0][m][0] * acc[ai][1][m][0] * r2, acc[ai][0][m][1] * acc[ai][1][m][1] * r2); }
            } else {
#pragma unroll
                for (int ai = 0; ai < 2; ++ai)
#pragma unroll
                    for (int m = 0; m < 4; ++m) { gbf rowp = O1 + (size_t)(row0 + ai * HALF + m * 16) * ldc + (u.pn - 8) * BM + cl; const float r = rv[ai][m];
#pragma unroll
                        for (int bj = 0; bj < 2; ++bj) st8(rowp + bj * HALF, acc[ai][bj][m][0] * r, acc[ai][bj][m][1] * r); }
            }
        } else if (mode == EM_KV) {
            if (u.pn < 8) { gbf base = (u.pn < 4) ? O0 : O1; const int ct = (u.pn & 3) * BM + cl;
#pragma unroll
                for (int ai = 0; ai < 2; ++ai)
#pragma unroll
                    for (int m = 0; m < 4; ++m) { gbf rowp = base + (size_t)(row0 + ai * HALF + m * 16) * ldc + ct; const float r = rv[ai][m];
#pragma unroll
                        for (int bj = 0; bj < 2; ++bj) st8(rowp + bj * HALF, acc[ai][bj][m][0] * r, acc[ai][bj][m][1] * r); }
            } else if (wc == 0 && fq < 2) {
#pragma unroll
                for (int ai = 0; ai < 2; ++ai)
#pragma unroll
                    for (int m = 0; m < 4; ++m) { gf32 fp = F + (size_t)(row0 + ai * HALF + m * 16) * 16 + 8 * fq;
                        *(__attribute__((address_space(1))) f32x4*)fp = acc[ai][0][m][0] * rv[ai][m]; *(__attribute__((address_space(1))) f32x4*)(fp + 4) = acc[ai][0][m][1] * rv[ai][m]; }
            }
        } else {
            const bool isq = u.pn < 4; gbf base = isq ? O0 : O1; const int ct = (u.pn & 3) * BM + cl;
#pragma unroll
            for (int ai = 0; ai < 2; ++ai)
#pragma unroll
                for (int m = 0; m < 4; ++m) { gbf rowp = base + (size_t)(row0 + ai * HALF + m * 16) * ldc + ct;
#pragma unroll
                    for (int bj = 0; bj < 2; ++bj) { f32x4 v0 = acc[ai][bj][m][0] * rv[ai][m], v1 = acc[ai][bj][m][1] * rv[ai][m];
                        if (isq) { v0 = v0 * qscale; v1 = v1 * qscale; } else { v0 = sigm(v0); v1 = sigm(v1); }
                        st8(rowp + bj * HALF, v0, v1); } }
        }
    }
};
}
#ifndef PG8_SP2
#define PG8_SP2 true
#endif
#include <hip/hip_bf16.h>
#include <cmath>
namespace attn_body {
using bf16=__hip_bfloat16;
using bf16x8=__attribute__((ext_vector_type(8)))short;
using s16x4=__attribute__((ext_vector_type(4)))short;
using f32x16=__attribute__((ext_vector_type(16)))float;
using u32x4=__attribute__((ext_vector_type(4)))unsigned;
using f32x4_t=__attribute__((ext_vector_type(4)))float;
constexpr int BATCH=16,NHEAD=16,SEQ=2048,D=64,DM=NHEAD*D;
constexpr int NW=8,QBLK=32,QB=QBLK*NW,KVBLK=64,NQB=SEQ/QB;
constexpr int ATTN_PITCH=DM, ATTN_UNIT_ROWS=QB;
__device__ __forceinline__ int crow(int r,int hi){return (r&3)+8*(r>>2)+4*hi;}
#define SBAR() __builtin_amdgcn_sched_barrier(0)
__device__ __forceinline__ void cmask(f32x16&p0,f32x16&p1,int jb,int qrel,int hi){
  const float NEG=-INFINITY; int kb=64*jb+4*hi;
  #pragma unroll
  for(int r=0;r<16;++r){int kv=kb+(r&3)+8*(r>>2); if(kv>qrel)p0[r]=NEG; if(kv+32>qrel)p1[r]=NEG;}
}

constexpr int NSLOT=3, SLOTB=8192;
constexpr int LDS_K=0, LDS_V=NSLOT*SLOTB, LDS_WS=2*NSLOT*SLOTB, LDS_OST=LDS_WS+NW*64*4, LDS_CT=LDS_OST+NW*4096, LDS_BYTES=LDS_CT+SEQ*4;
constexpr float C2=0.125f*1.4426950408889634f;
__device__ __forceinline__ void glds16(const void*gsrc,unsigned lds_dst){unsigned keep;
  asm volatile("s_mov_b32 %0, m0\n\ts_mov_b32 m0, %2\n\ts_nop 0\n\tglobal_load_lds_dwordx4 %1, off\n\ts_mov_b32 m0, %0":"=&s"(keep):"v"(gsrc),"s"(lds_dst):"memory");}
__device__ __forceinline__ float max3f(float a,float b,float c){float r;asm("v_max3_f32 %0, %1, %2, %3":"=v"(r):"v"(a),"v"(b),"v"(c));return r;}
__device__ __forceinline__ float max2f(float a,float b){float r;asm("v_max_f32_e32 %0, %1, %2":"=v"(r):"v"(a),"v"(b));return r;}
__device__ __forceinline__ float fadd_s(float a,float b){float r;asm("v_add_f32_e32 %0, %1, %2":"=v"(r):"v"(a),"v"(b));return r;}
__device__ __forceinline__ float fsub_s(float a,float b){float r;asm("v_sub_f32_e32 %0, %1, %2":"=v"(r):"v"(a),"v"(b));return r;}
typedef float f32x2_t __attribute__((ext_vector_type(2))); typedef __bf16 bf16x2_t __attribute__((ext_vector_type(2)));
__device__ __forceinline__ unsigned cvtpk_s(float lo,float hi){f32x2_t v={lo,hi};bf16x2_t b=__builtin_convertvector(v,bf16x2_t);return __builtin_bit_cast(unsigned,b);}
#define WAIT_BAR(N) asm volatile("s_waitcnt vmcnt(" #N ") lgkmcnt(0)\n\ts_barrier":::"memory")

__device__ __forceinline__ void qkt(f32x16&p0,f32x16&p1,const char*Kslot,const bf16x8*qr,int r32,int hi){
  const char*kb=Kslot+hi*1024+r32*16;
  #pragma unroll
  for(int d0=0;d0<4;++d0){
    const bf16x8 b0=*reinterpret_cast<const bf16x8*>(kb+d0*2048);
    const bf16x8 b1=*reinterpret_cast<const bf16x8*>(kb+d0*2048+512);
    p0=__builtin_amdgcn_mfma_f32_32x32x16_bf16(b0,qr[d0],p0,0,0,0);p1=__builtin_amdgcn_mfma_f32_32x32x16_bf16(b1,qr[d0],p1,0,0,0);}
}
typedef __attribute__((address_space(3))) const char* lds_cptr;
typedef short v4i16_t __attribute__((ext_vector_type(4)));
__device__ __forceinline__ void kload8(bf16x8*kf,lds_cptr kp){
  kf[0]=*(const __attribute__((address_space(3))) bf16x8*)(kp);      kf[1]=*(const __attribute__((address_space(3))) bf16x8*)(kp+512);
  kf[2]=*(const __attribute__((address_space(3))) bf16x8*)(kp+2048); kf[3]=*(const __attribute__((address_space(3))) bf16x8*)(kp+2560);
  kf[4]=*(const __attribute__((address_space(3))) bf16x8*)(kp+4096); kf[5]=*(const __attribute__((address_space(3))) bf16x8*)(kp+4608);
  kf[6]=*(const __attribute__((address_space(3))) bf16x8*)(kp+6144); kf[7]=*(const __attribute__((address_space(3))) bf16x8*)(kp+6656);
}
__device__ __forceinline__ void kload2(bf16x8*kf,lds_cptr kp,int j){ kf[2*j]=*(const __attribute__((address_space(3))) bf16x8*)(kp+j*2048); kf[2*j+1]=*(const __attribute__((address_space(3))) bf16x8*)(kp+j*2048+512); }
__device__ __forceinline__ s16x4 vtr(lds_cptr p){ return __builtin_bit_cast(s16x4,__builtin_amdgcn_ds_read_tr16_b64_v4i16((__attribute__((address_space(3))) v4i16_t*)p)); }
__device__ __forceinline__ float rowmax(const f32x16&p0,const f32x16&p1){
  float a=max3f(p0[0],p0[1],p1[0]),b=max3f(p0[2],p0[3],p1[1]);a=max3f(a,p1[2],p1[3]);
  #pragma unroll
  for(int r=4;r<16;r+=4){a=max3f(a,p0[r],p0[r+1]);b=max3f(b,p0[r+2],p0[r+3]);a=max3f(a,p1[r],p1[r+1]);b=max3f(b,p1[r+2],p1[r+3]);}
  const float m=max2f(a,b);
  auto rr=__builtin_amdgcn_permlane32_swap(__float_as_uint(m),__float_as_uint(m),false,false);
  return max2f(__uint_as_float(rr[0]),__uint_as_float(rr[1]));
}
__device__ __forceinline__ void pv(f32x16*o,int vb,bf16x8 pa0,bf16x8 pa1,bf16x8 pa2,bf16x8 pa3){
  #pragma unroll
  for(int d0=0;d0<2;++d0){s16x4 lo[4],hi[4];
    #pragma unroll
    for(int ks=0;ks<4;++ks){
      asm volatile("ds_read_b64_tr_b16 %0,%1 offset:%c2":"=&v"(lo[ks]):"v"(vb),"i"(d0*4096+ks*1024):"memory");
      asm volatile("ds_read_b64_tr_b16 %0,%1 offset:%c2":"=&v"(hi[ks]):"v"(vb),"i"(d0*4096+ks*1024+512):"memory");}
    asm volatile("s_waitcnt lgkmcnt(0)":::"memory");SBAR();
    #define PK(k) (bf16x8){lo[k][0],lo[k][1],lo[k][2],lo[k][3],hi[k][0],hi[k][1],hi[k][2],hi[k][3]}
    o[d0]=__builtin_amdgcn_mfma_f32_32x32x16_bf16(pa0,PK(0),o[d0],0,0,0);
    o[d0]=__builtin_amdgcn_mfma_f32_32x32x16_bf16(pa1,PK(1),o[d0],0,0,0);
    o[d0]=__builtin_amdgcn_mfma_f32_32x32x16_bf16(pa2,PK(2),o[d0],0,0,0);
    o[d0]=__builtin_amdgcn_mfma_f32_32x32x16_bf16(pa3,PK(3),o[d0],0,0,0);
    #undef PK
  }
}

#ifndef ATTN_STORE16
#define ATTN_STORE16(p,v) (*(u32x4*)(p)=(v))
#endif
template<int THRL> __device__ __forceinline__ void attn_unit(int b,int h,int qb,const bf16*Q,const bf16*__restrict__ K,const bf16*__restrict__ V,bf16*O,const bf16*__restrict__ GT,const float*__restrict__ C2T,bool load_ct,char*shm,const int tid){
  const int lane=tid&63,r32=lane&31,hi=lane>>5; const int wid=__builtin_amdgcn_readfirstlane(tid>>6);
  const long rowbase=(long)b*SEQ; const int q0=qb*QB;
  const bf16*Qw=Q+(rowbase+q0+wid*QBLK)*DM+h*D;
  const bf16*Kh=K+rowbase*DM+h*D,*Vh=V+rowbase*DM+h*D;
  const unsigned lds0=(unsigned)(uintptr_t)shm;
  float*wsf=(float*)(shm+LDS_WS)+wid*64;
  typedef __attribute__((address_space(3))) f32x4_t* lds_f4p;
  const float*c2row=C2T+((long)b*NHEAD+h)*SEQ;
  if(load_ct){ const f32x4_t cv=*reinterpret_cast<const f32x4_t*>(c2row+tid*4); asm volatile("s_waitcnt vmcnt(0)":::"memory"); *((lds_f4p)(shm+LDS_CT)+tid)=cv; }
  const float cq=c2row[qb*QB+wid*QBLK+r32];
  const __attribute__((address_space(3))) f32x4_t* ctab=(const __attribute__((address_space(3))) f32x4_t*)(shm+LDS_CT)+hi;
  #define CINIT(P0,P1,t) do{ const __attribute__((address_space(3))) f32x4_t* cp_=ctab+(t)*16; const float nm_=cq-mhat; \
    _Pragma("unroll") for(int j_=0;j_<4;++j_){ const f32x4_t a_=cp_[2*j_], b_=cp_[8+2*j_]; \
      P0[4*j_]=nm_-a_[0];P0[4*j_+1]=nm_-a_[1];P0[4*j_+2]=nm_-a_[2];P0[4*j_+3]=nm_-a_[3]; P1[4*j_]=nm_-b_[0];P1[4*j_+1]=nm_-b_[1];P1[4*j_+2]=nm_-b_[2];P1[4*j_+3]=nm_-b_[3]; } }while(0)
  const bf16*ksrc=Kh+(long)lane*DM+wid*8;
  const bf16*vsrc=Vh+(long)(16*(wid&3)+(lane>>2))*DM+(wid>>2)*32+(lane&3)*8;
  const unsigned kdst=lds0+LDS_K+wid*1024, vdst=lds0+LDS_V+wid*1024;
  #define DMA_K(t,slot) glds16(ksrc+(long)(t)*KVBLK*DM,(unsigned)__builtin_amdgcn_readfirstlane(kdst+(slot)))
  #define DMA_V(t,slot) glds16(vsrc+(long)(t)*KVBLK*DM,(unsigned)__builtin_amdgcn_readfirstlane(vdst+(slot)))
  const int vb0=(int)(lds0+LDS_V)+((lane>>4)&1)*32+(lane&3)*8+(4*hi+((lane&15)>>2))*64;
  const char*Kbase=shm+LDS_K; bf16x8 kf[8];
  const lds_cptr shm3=(lds_cptr)shm; const lds_cptr kp0=shm3+LDS_K+hi*1024+r32*16; const lds_cptr vp0=shm3+LDS_V+((lane>>4)&1)*32+(lane&3)*8+(4*hi+((lane&15)>>2))*64;
  const int NT=(q0+QB)/KVBLK;
  DMA_K(0,0);DMA_V(0,0);DMA_K(1,SLOTB);
  bf16x8 qr[4];
  #pragma unroll
  for(int d0=0;d0<4;++d0)qr[d0]=*reinterpret_cast<const bf16x8*>(&Qw[(long)r32*DM+d0*16+hi*8]);
  float mhat=0.f,l_reg=0.f;f32x16 o[2];o[0]=f32x16{};o[1]=f32x16{};
  const int qrel=wid*QBLK+r32;
  #define CMASK(P0,P1,t) do{int jb_=(t)-(NT-4); if(jb_>=0)cmask(P0,P1,jb_,qrel,hi);}while(0)
  bool resc=false;
  #define START(P0,P1) do{ const float rm=rowmax(P0,P1); resc=false; \
    { const float dl=rm; mhat=fadd_s(mhat,dl); \
      _Pragma("unroll") for(int r=0;r<16;++r){P0[r]=fsub_s(P0[r],dl);P1[r]=fsub_s(P1[r],dl);} \
      } \
    _Pragma("unroll") for(int r=0;r<16;++r)P0[r]=__builtin_amdgcn_exp2f(P0[r]); }while(0)
  #define RESC() do{ if(resc){ asm volatile("s_waitcnt lgkmcnt(0)":::"memory"); \
      _Pragma("unroll") for(int d_=0;d_<2;++d_) _Pragma("unroll") for(int r=0;r<16;++r)o[d_][r]*=wsf[crow(r,hi)]; } }while(0)
  f32x16 pA0,pA1,pB0,pB1;
  int sl_prev=0,sl_cur=0,sl_next=SLOTB;
  #define ROT() do{sl_prev=sl_cur;sl_cur=sl_next;sl_next=(sl_next==(NSLOT-1)*SLOTB)?0:sl_next+SLOTB;}while(0)
  DMA_K(2,2*SLOTB);
  WAIT_BAR(3);
  CINIT(pA0,pA1,0);
  qkt(pA0,pA1,Kbase,qr,r32,hi);asm volatile("s_nop 15\n\ts_nop 7":"+v"(pA0),"+v"(pA1));CMASK(pA0,pA1,0);
  START(pA0,pA1);
  _Pragma("unroll") for(int r=0;r<16;++r)pA1[r]=__builtin_amdgcn_exp2f(pA1[r]);
  WAIT_BAR(0);
  DMA_K(3,0);DMA_V(1,SLOTB);
  ROT();
  kload8(kf,kp0+sl_cur);
  WAIT_BAR(2);
  s16x4 vlo[8],vhi[8]; u32x4 pw0,pw1,pw2,pw3;
  #define PKW(P,B) cvtpk_s(P[B],P[B+1])
  #define PAF(k) __builtin_bit_cast(bf16x8,pw##k)
  #define VFR(i) (bf16x8){vlo[i][0],vlo[i][1],vlo[i][2],vlo[i][3],vhi[i][0],vhi[i][1],vhi[i][2],vhi[i][3]}
  #define PIN(x) asm volatile("":"+v"(x))
  #define MX3(a,b,c) __builtin_fmaxf(__builtin_fmaxf((a),(b)),(c))
  #define GAPA(MF,A0,A1,A2,A3,W0,W1,PW) do{ MF; sacc+=A0; sacc+=A1; sacc+=A2; sacc+=A3; PIN(sacc); W0; W1; PIN(PW); SBAR(); }while(0)
  #define EX(v) __builtin_amdgcn_exp2f(v)
  #define GAPB(MF,X,B) do{ MF; X[B]=EX(X[B]); X[B+1]=EX(X[B+1]); X[B+2]=EX(X[B+2]); X[B+3]=EX(X[B+3]); PIN(X); SBAR(); }while(0)
  #define VRD(i) do{ vlo[i]=vtr(vp_+(((i)>>2)*4096+((i)&3)*1024)); vhi[i]=vtr(vp_+(((i)>>2)*4096+((i)&3)*1024+512)); }while(0)
  #define KRD(G,j) do{ if(G){ kload2(kf,kp0+sl_next,j); SBAR(); } }while(0)
  #define STEP(C0,C1,P0,P1,t,GK,GV,GL) do{ SBAR(); CINIT(C0,C1,t); SBAR(); \
    const lds_cptr vp_=vp0+sl_prev; \
    VRD(0); SBAR(); float sacc=(P0[0]+P0[1]); \
    GAPA(C0=__builtin_amdgcn_mfma_f32_32x32x16_bf16(kf[0],qr[0],C0,0,0,0), P0[2],P0[3],P0[4],P0[5],     pw0[0]=PKW(P0,0), pw0[1]=PKW(P0,2), pw0); \
    VRD(4); SBAR(); GAPA(C1=__builtin_amdgcn_mfma_f32_32x32x16_bf16(kf[1],qr[0],C1,0,0,0), P0[6],P0[7],P0[8],P0[9],     pw0[2]=PKW(P0,4), pw0[3]=PKW(P0,6), pw0); \
    VRD(1); SBAR(); GAPA(C0=__builtin_amdgcn_mfma_f32_32x32x16_bf16(kf[2],qr[1],C0,0,0,0),   P0[10],P0[11],P0[12],P0[13], pw1[0]=PKW(P0,8), pw1[1]=PKW(P0,10), pw1); \
    VRD(5); SBAR(); GAPA(C1=__builtin_amdgcn_mfma_f32_32x32x16_bf16(kf[3],qr[1],C1,0,0,0),   P0[14],P0[15],P1[0],P1[1],   pw1[2]=PKW(P0,12),pw1[3]=PKW(P0,14), pw1); \
    VRD(2); SBAR(); GAPA(C0=__builtin_amdgcn_mfma_f32_32x32x16_bf16(kf[4],qr[2],C0,0,0,0),   P1[2],P1[3],P1[4],P1[5],     pw2[0]=PKW(P1,0), pw2[1]=PKW(P1,2), pw2); \
    VRD(6); SBAR(); GAPA(C1=__builtin_amdgcn_mfma_f32_32x32x16_bf16(kf[5],qr[2],C1,0,0,0),   P1[6],P1[7],P1[8],P1[9],     pw2[2]=PKW(P1,4), pw2[3]=PKW(P1,6), pw2); \
    VRD(3); SBAR(); GAPA(C0=__builtin_amdgcn_mfma_f32_32x32x16_bf16(kf[6],qr[3],C0,0,0,0),   P1[10],P1[11],P1[12],P1[13], pw3[0]=PKW(P1,8), pw3[1]=PKW(P1,10), pw3); \
    VRD(7); SBAR(); GAPA(C1=__builtin_amdgcn_mfma_f32_32x32x16_bf16(kf[7],qr[3],C1,0,0,0),   P1[14],P1[15],0.f,0.f,       pw3[2]=PKW(P1,12),pw3[3]=PKW(P1,14), pw3); \
    l_reg+=sacc; \
    if(GK){DMA_K((t)+3,sl_cur);} if(GV){DMA_V((t)+1,sl_next);} \
    CMASK(C0,C1,t); \
    { float a=MX3(C0[0],C0[1],C1[0]),b=MX3(C0[2],C0[3],C1[1]); a=MX3(a,C1[2],C1[3]); \
      _Pragma("unroll") for(int r=4;r<16;r+=4){a=MX3(a,C0[r],C0[r+1]);b=MX3(b,C0[r+2],C0[r+3]);a=MX3(a,C1[r],C1[r+1]);b=MX3(b,C1[r+2],C1[r+3]);} \
      float rm=__builtin_fmaxf(a,b); { auto rr=__builtin_amdgcn_permlane32_swap(__float_as_uint(rm),__float_as_uint(rm),false,false); rm=__builtin_fmaxf(__uint_as_float(rr[0]),__uint_as_float(rr[1])); } \
      resc=false; \
      if(__builtin_expect(__any(rm>(float)THRL),0)){ const float dl=__builtin_fmaxf(rm,0.f); mhat+=dl; \
        _Pragma("unroll") for(int r=0;r<16;++r){C0[r]-=dl;C1[r]-=dl;} \
        const float f=__builtin_amdgcn_exp2f(-dl); l_reg*=f; if(hi==0)wsf[r32]=f; resc=true; } } \
    SBAR(); \
    GAPB(o[0]=__builtin_amdgcn_mfma_f32_32x32x16_bf16(PAF(0),VFR(0),o[0],0,0,0), C0,0); \
    GAPB(o[1]=__builtin_amdgcn_mfma_f32_32x32x16_bf16(PAF(0),VFR(4),o[1],0,0,0), C0,4); \
    KRD(GL,0); GAPB(o[0]=__builtin_amdgcn_mfma_f32_32x32x16_bf16(PAF(1),VFR(1),o[0],0,0,0), C0,8); \
    KRD(GL,1); GAPB(o[1]=__builtin_amdgcn_mfma_f32_32x32x16_bf16(PAF(1),VFR(5),o[1],0,0,0), C0,12); \
    KRD(GL,2); GAPB(o[0]=__builtin_amdgcn_mfma_f32_32x32x16_bf16(PAF(2),VFR(2),o[0],0,0,0), C1,0); \
    KRD(GL,3); GAPB(o[1]=__builtin_amdgcn_mfma_f32_32x32x16_bf16(PAF(2),VFR(6),o[1],0,0,0), C1,4); \
    GAPB(o[0]=__builtin_amdgcn_mfma_f32_32x32x16_bf16(PAF(3),VFR(3),o[0],0,0,0), C1,8); \
    GAPB(o[1]=__builtin_amdgcn_mfma_f32_32x32x16_bf16(PAF(3),VFR(7),o[1],0,0,0), C1,12); \
    }while(0)
  int t=1;
  #undef CMASK
  #define CMASK(P0,P1,t) do{}while(0)
  for(;t+5<NT;t+=2){
    STEP(pB0,pB1,pA0,pA1,t,true,true,true);     WAIT_BAR(2); RESC(); ROT();
    STEP(pA0,pA1,pB0,pB1,t+1,true,true,true);   WAIT_BAR(2); RESC(); ROT();
  }
  #undef CMASK
  #define CMASK(P0,P1,t) do{int jb_=(t)-(NT-4); if(jb_>=0)cmask(P0,P1,jb_,qrel,hi);}while(0)
  #define ENDW(tt) do{ if((tt)+3<NT){WAIT_BAR(2);} else if((tt)+2<NT){WAIT_BAR(1);} else {WAIT_BAR(0);} }while(0)
  for(;t+1<NT;t+=2){
    STEP(pB0,pB1,pA0,pA1,t,(t+3<NT),(t+1<NT),(t+1<NT));       ENDW(t);   RESC(); ROT();
    STEP(pA0,pA1,pB0,pB1,t+1,(t+4<NT),(t+2<NT),(t+2<NT));     ENDW(t+1); RESC(); ROT();
  }
  STEP(pB0,pB1,pA0,pA1,NT-1,false,false,false); RESC();
  { float sacc=pB0[0]+pB0[1]; _Pragma("unroll") for(int r=2;r<16;++r)sacc+=pB0[r]; _Pragma("unroll") for(int r=0;r<16;++r)sacc+=pB1[r]; l_reg+=sacc;
    pw0=(u32x4){PKW(pB0,0),PKW(pB0,2),PKW(pB0,4),PKW(pB0,6)};pw1=(u32x4){PKW(pB0,8),PKW(pB0,10),PKW(pB0,12),PKW(pB0,14)};pw2=(u32x4){PKW(pB1,0),PKW(pB1,2),PKW(pB1,4),PKW(pB1,6)};pw3=(u32x4){PKW(pB1,8),PKW(pB1,10),PKW(pB1,12),PKW(pB1,14)};
    SBAR(); pv(o,vb0+sl_cur,PAF(0),PAF(1),PAF(2),PAF(3)); }
  #undef PKW
  #undef PAF
  #undef VFR
  #undef PIN
  #undef MX3
  #undef GAPA
  #undef GAPB
  #undef EX
  #undef VRD
  #undef KRD
  #undef STEP
  #undef ENDW
  {auto rr=__builtin_amdgcn_permlane32_swap(__float_as_uint(l_reg),__float_as_uint(l_reg),false,false);l_reg=__uint_as_float(rr[0])+__uint_as_float(rr[1]);}
  if(hi==0)wsf[32+r32]=l_reg;asm volatile("s_waitcnt lgkmcnt(0)":::"memory");
  float rli[16];
  #pragma unroll
  for(int r=0;r<16;++r)rli[r]=__builtin_amdgcn_rcpf(wsf[32+crow(r,hi)]);
  bf16*Ow=O+(rowbase+q0+wid*QBLK)*DM+h*D;
  { bf16*stg=(bf16*)(shm+LDS_OST)+wid*2048;
    #pragma unroll
    for(int r=0;r<16;++r){const int orow=crow(r,hi);
      #pragma unroll
      for(int d0=0;d0<2;++d0)stg[orow*64+d0*32+r32]=__float2bfloat16(o[d0][r]*rli[r]);}
    asm volatile("s_waitcnt lgkmcnt(0)":::"memory");
    const bf16*Gw=GT+(rowbase+q0+wid*QBLK)*DM+h*D;
    u32x4 gv[4];
    #pragma unroll
    for(int i=0;i<4;++i){const int row=i*8+(lane>>3),ch=lane&7; gv[i]=*(const u32x4*)(Gw+(long)row*DM+ch*8);}
    #pragma unroll
    for(int i=0;i<4;++i){const int row=i*8+(lane>>3),ch=lane&7; u32x4 v=*(const u32x4*)(stg+row*64+ch*8);
      #pragma unroll
      for(int e=0;e<4;++e){ const float o0=__uint_as_float(v[e]<<16)*__uint_as_float(gv[i][e]<<16), o1=__uint_as_float(v[e]&0xffff0000u)*__uint_as_float(gv[i][e]&0xffff0000u); v[e]=cvtpk_s(o0,o1); }
      ATTN_STORE16(Ow+(long)row*DM+ch*8,v);} }
  asm volatile("s_waitcnt lgkmcnt(0)\n\ts_barrier":::"memory");
  #undef CINIT
  #undef DMA_K
  #undef DMA_V
  #undef CMASK
  #undef START
  #undef RESC
  #undef ROT
}
constexpr int ATTN_LDS_BYTES=LDS_BYTES;
struct AttnTensors { const bf16* Q; const bf16* K; const bf16* V; bf16* O; const bf16* G; const float* C2; };
struct AttnUnit { int bh; int qb; };
struct StaticOrder {
  int vcu, G;
  __device__ __forceinline__ explicit StaticOrder(int grid,int block):vcu((grid%8==0)?(block%8)*(grid/8)+block/8:block),G(grid){}
  __device__ __forceinline__ bool next(int i,AttnUnit&u)const{ const int bh=vcu+(i>>3)*G; if(bh>=BATCH*NHEAD)return false; u.bh=bh; u.qb=7-(i&7); return true; }
  __device__ __forceinline__ void a_ready(const AttnUnit&)const{}
  __device__ __forceinline__ void done(const AttnUnit&)const{}
};
template<class Sched,int THRL=8> __device__ __forceinline__ void attn_phase(char*lds,const AttnTensors&T,const Sched&S,const int tid){
  AttnUnit u;
  for(int i=0;S.next(i,u);++i){ S.a_ready(u); attn_unit<THRL>(u.bh/NHEAD,u.bh%NHEAD,u.qb,T.Q,T.K,T.V,T.O,T.G,T.C2,(i&7)==0,lds,tid); S.done(u); }
}
#undef SBAR
#undef WAIT_BAR
}
constexpr int NWAVES = 8;
constexpr int BATCH = 16, SEQ = 2048, D = 1024, NH = 16, FF = 2816, FF2 = 2 * FF;
constexpr int M = BATCH * SEQ;
constexpr int NKV = 2304;
constexpr float RMS_EPS = 1e-6f;
static_assert(attn_body::BATCH == BATCH && attn_body::SEQ == SEQ && attn_body::DM == D, "attention body geometry");
constexpr size_t MiB = 1u << 20;
constexpr size_t WS_CTL = 0, CTL_ZERO_BYTES = 65536;
constexpr int CW_BAR = 4096;
constexpr size_t WS_WFI = 2 * MiB;
constexpr size_t WS_WFO = 46 * MiB;
constexpr size_t WS_WCI = 68 * MiB;
constexpr size_t WS_WCO = 74 * MiB;
constexpr size_t WS_WKV = 76 * MiB;
constexpr size_t WS_WQG = 81 * MiB;
constexpr size_t WS_WO = 85 * MiB;
constexpr size_t WS_FL = 88 * MiB;
constexpr size_t WS_C2 = 90 * MiB;
constexpr size_t WS_RS = 92 * MiB;
constexpr size_t WS_XH = 96 * MiB;
constexpr size_t WS_R = 160 * MiB;
constexpr size_t WS_K = 352 * MiB, WS_V = 416 * MiB, WS_END = 480 * MiB;
static_assert(WS_WFI + 4 * (size_t)FF2 * D * 2 <= WS_WFO && WS_WFO + 4 * (size_t)D * FF * 2 <= WS_WCI && WS_WKV + (size_t)NKV * D * 2 <= WS_WQG && WS_R + (size_t)M * FF * 2 <= WS_K, "d_ws map");
constexpr int RING_BYTES = 131072, LDS_BYTES = 147456;
static_assert(attn_body::ATTN_LDS_BYTES <= RING_BYTES && pg8::STAGE_BYTES <= RING_BYTES, "LDS map");

#define GAS __attribute__((address_space(1)))
#define LAS __attribute__((address_space(3)))
typedef unsigned short bf16;
typedef unsigned v4u __attribute__((ext_vector_type(4)));
typedef unsigned v2u __attribute__((ext_vector_type(2)));
typedef float f32x4 __attribute__((ext_vector_type(4)));
#define LDS_WAIT() asm volatile("s_waitcnt lgkmcnt(0)" ::: "memory")
__device__ __forceinline__ unsigned f2bf(float f) { unsigned u = __builtin_bit_cast(unsigned, f); return (u + 0x7fffu + ((u >> 16) & 1u)) >> 16; }
__device__ __forceinline__ unsigned pk2(float lo, float hi) { return f2bf(lo) | (f2bf(hi) << 16); }
__device__ __forceinline__ float bflo(unsigned w) { return __uint_as_float(w << 16); }
__device__ __forceinline__ float bfhi(unsigned w) { return __uint_as_float(w & 0xffff0000u); }

struct Frame { LAS unsigned char* lds; int tid, lane, wave, vcu, G; };

__device__ __forceinline__ float wave_sum(float v) {
#pragma unroll
    for (int o = 1; o < 64; o <<= 1) v += __shfl_xor(v, o);
    return v;
}
#define XB_TMO      128
#define XB_XCNT(j)  (256  + 64 * (j))
#define XB_XSUB(j)  (1280 + 64 * (j))
#define XB_XGEN(j)  (2304 + 64 * (j))
#define XB_TOP      3328
#define XB_TOPGEN   3392
#define XCD_BAR_WORDS 3456
#define XB_SPIN_CAP (1u << 18)

__device__ __forceinline__ unsigned xb_ld(unsigned* p)              { return __hip_atomic_load(p, __ATOMIC_RELAXED, __HIP_MEMORY_SCOPE_AGENT); }
__device__ __forceinline__ unsigned xb_add(unsigned* p, unsigned v) { return __hip_atomic_fetch_add(p, v, __ATOMIC_RELAXED, __HIP_MEMORY_SCOPE_AGENT); }
__device__ __forceinline__ unsigned xb_xcc_id() { return (unsigned)__builtin_amdgcn_s_getreg((3 << 11) | 20) & 0xFu; }
#define XB_SPIN(cond, bar) do { unsigned _sp = 0; while (cond) { __builtin_amdgcn_s_sleep(1); \
    if ((++_sp & 255u) == 0u) { if (xb_ld(&(bar)[XB_TMO])) break; if (_sp > XB_SPIN_CAP) { atomicAdd(&(bar)[XB_TMO], 1u); break; } } } } while (0)

struct XcdBarrier {
    unsigned* bar; unsigned x;
    volatile LAS unsigned* st;
};

__device__ __forceinline__ XcdBarrier xcd_barrier_post(unsigned* bar, volatile LAS unsigned* st) {
    XcdBarrier b; b.bar = bar; b.x = xb_xcc_id(); b.st = st;
    if (threadIdx.x == 0) (void)xb_add(&bar[XB_XCNT(b.x)], 1u);
    return b;
}
__device__ __forceinline__ void xcd_barrier_complete(unsigned* bar, unsigned x, unsigned& nloc, unsigned& nx) {
    const unsigned G = gridDim.x * gridDim.y * gridDim.z;
    unsigned sum, cnt, mine, sp = 0u;
    for (;;) {
        sum = 0u; cnt = 0u; mine = 0u;
#pragma unroll
        for (unsigned j = 0; j < 16; ++j) { const unsigned c = xb_ld(&bar[XB_XCNT(j)]); sum += c; cnt += (c > 0u) ? 1u : 0u; mine = (j == x) ? c : mine; }
        if (sum == G) break;
        __builtin_amdgcn_s_sleep(1);
        if ((++sp & 255u) == 0u) { if (xb_ld(&bar[XB_TMO])) break; if (sp > XB_SPIN_CAP) { atomicAdd(&bar[XB_TMO], 1u); break; } }
    }
    nloc = mine > 0u ? mine : 1u; nx = cnt > 0u ? cnt : 1u;
}

__device__ __forceinline__ void xcd_barrier(const XcdBarrier& b) {
    asm volatile("s_waitcnt vmcnt(0)" ::: "memory");
    __syncthreads();
    if (threadIdx.x == 0) {
        unsigned* bar = b.bar;
        __builtin_amdgcn_s_waitcnt(0);
        unsigned nloc = b.st[0], nx = b.st[1];
        if (nloc == 0u) { xcd_barrier_complete(bar, b.x, nloc, nx); b.st[0] = nloc; b.st[1] = nx; }
        const unsigned old = xb_add(&bar[XB_XSUB(b.x)], 1u);
        const unsigned gen = old / nloc;
        if (old + 1u == (gen + 1u) * nloc) {
            __builtin_amdgcn_fence(__ATOMIC_RELEASE, "agent");
            asm volatile("s_waitcnt vmcnt(0)" ::: "memory");
            const unsigned og = xb_add(&bar[XB_TOP], 1u);
            const unsigned tg = og / nx;
            if (og + 1u == (tg + 1u) * nx) xb_add(&bar[XB_TOPGEN], 1u);
            else XB_SPIN(xb_ld(&bar[XB_TOPGEN]) == tg, bar);
            __builtin_amdgcn_fence(__ATOMIC_ACQUIRE, "agent");
            xb_add(&bar[XB_XGEN(b.x)], 1u);
            asm volatile("s_waitcnt vmcnt(0)" ::: "memory");
        } else {
            XB_SPIN(xb_ld(&bar[XB_XGEN(b.x)]) == gen, bar);
            __builtin_amdgcn_fence(__ATOMIC_ACQUIRE, "agent");
            asm volatile("s_waitcnt vmcnt(0)" ::: "memory");
        }
    }
    __syncthreads();
}

enum { MAP_PLAIN = 0, MAP_SWIGLU = 1, MAP_CONV = 2 };
__device__ __forceinline__ int map_row(int mode, int n0) {
    if (mode == MAP_SWIGLU) { const int up = n0 >= FF ? 1 : 0, j = n0 - up * FF; return 256 * (j >> 7) + 128 * up + (j & 127); }
    if (mode == MAP_CONV) { if (n0 < D) return 2 * D + n0; const int hh = n0 >= 2 * D ? 1 : 0, j = n0 - D - hh * D; return 256 * (j >> 7) + 128 * hh + (j & 127); }
    return n0;
}
__device__ __forceinline__ void cvt_item(const float* W, int ldw, int K, int ncols, const float* gain, bf16* WT, int mode, LAS float* scr, int item, int lane) {
    const int nblk = ncols / 32, kb = item / nblk, nb = item % nblk, k0 = 64 * kb, n0 = 32 * nb;
#pragma unroll 8
    for (int i = 0; i < 32; ++i) { const int kk = 2 * i + (lane >> 5); scr[kk * 33 + (lane & 31)] = W[(size_t)(k0 + kk) * ldw + n0 + (lane & 31)]; }
    const int c = lane & 7, drow = map_row(mode, n0);
    f32x4 g0 = (f32x4){1.f, 1.f, 1.f, 1.f}, g1 = g0;
    if (gain) { g0 = *(const f32x4*)(gain + k0 + 8 * c); g1 = *(const f32x4*)(gain + k0 + 8 * c + 4); }
    LDS_WAIT(); asm volatile("" ::: "memory");
#pragma unroll
    for (int j = 0; j < 4; ++j) { const int n = (lane >> 3) + 8 * j; const LAS float* s = scr + (8 * c) * 33 + n;
        v4u o; o.x = pk2(s[0 * 33] * g0[0], s[1 * 33] * g0[1]); o.y = pk2(s[2 * 33] * g0[2], s[3 * 33] * g0[3]); o.z = pk2(s[4 * 33] * g1[0], s[5 * 33] * g1[1]); o.w = pk2(s[6 * 33] * g1[2], s[7 * 33] * g1[3]);
        *(GAS v4u*)(WT + (size_t)(drow + n) * K + k0 + 8 * c) = o; }
    LDS_WAIT(); asm volatile("" ::: "memory");
}
struct Ptrs {
    const float *x, *ffn1_pre_g, *ffn1_post_g, *ffn1_w_in, *ffn1_w_out, *mix_pre_g, *mix_post_g, *ffn2_pre_g, *ffn2_post_g, *ffn2_w_in, *ffn2_w_out,
                *conv_w_in, *conv_k, *conv_w_out, *kv_g, *kv_w, *forget_b, *attn_w_qg, *attn_w_o;
};
__device__ __forceinline__ void convert_weights(const Frame& F, const Ptrs& P, unsigned char* ws) {
    LAS float* scr = (LAS float*)(F.lds + F.wave * 16384);
    const int gw = F.vcu * NWAVES + F.wave, NGW = F.G * NWAVES;
    constexpr int I_FI = (D / 64) * (FF2 / 32), I_FO = (FF / 64) * (D / 32), I_CI = (D / 64) * (3 * D / 32), I_DD = (D / 64) * (D / 32), I_2D = (D / 64) * (2 * D / 32);
    constexpr int NITEMS = 4 * I_FI + 4 * I_FO + I_CI + I_DD + I_2D + I_2D + I_DD;
    for (int it = gw; it < NITEMS; it += NGW) {
        int r = it;
        if (r < 4 * I_FI) { const int i = r / I_FI, l = i >> 1, w2 = i & 1; r -= i * I_FI;
            cvt_item((w2 ? P.ffn2_w_in : P.ffn1_w_in) + (size_t)l * D * FF2, FF2, D, FF2, (w2 ? P.ffn2_pre_g : P.ffn1_pre_g) + l * D, (bf16*)(ws + WS_WFI) + (size_t)i * FF2 * D, MAP_SWIGLU, scr, r, F.lane); continue; }
        r -= 4 * I_FI;
        if (r < 4 * I_FO) { const int i = r / I_FO, l = i >> 1, w2 = i & 1; r -= i * I_FO;
            cvt_item((w2 ? P.ffn2_w_out : P.ffn1_w_out) + (size_t)l * FF * D, D, FF, D, nullptr, (bf16*)(ws + WS_WFO) + (size_t)i * D * FF, MAP_PLAIN, scr, r, F.lane); continue; }
        r -= 4 * I_FO;
        if (r < I_CI) { cvt_item(P.conv_w_in, 3 * D, D, 3 * D, P.mix_pre_g, (bf16*)(ws + WS_WCI), MAP_CONV, scr, r, F.lane); continue; } r -= I_CI;
        if (r < I_DD) { cvt_item(P.conv_w_out, D, D, D, nullptr, (bf16*)(ws + WS_WCO), MAP_PLAIN, scr, r, F.lane); continue; } r -= I_DD;
        if (r < I_2D) { cvt_item(P.kv_w, 2 * D + NH, D, 2 * D, P.kv_g, (bf16*)(ws + WS_WKV), MAP_PLAIN, scr, r, F.lane); continue; } r -= I_2D;
        if (r < I_2D) { cvt_item(P.attn_w_qg, 2 * D, D, 2 * D, P.mix_pre_g + D, (bf16*)(ws + WS_WQG), MAP_PLAIN, scr, r, F.lane); continue; } r -= I_2D;
        cvt_item(P.attn_w_o, D, D, D, nullptr, (bf16*)(ws + WS_WO), MAP_PLAIN, scr, r, F.lane);
    }
    bf16* wkv = (bf16*)(ws + WS_WKV);
    const int gt = F.vcu * (NWAVES * 64) + F.tid, NGT = F.G * NWAVES * 64;
    for (int e = gt; e < NH * D; e += NGT) { const int n = e / D, k = e % D; wkv[(size_t)(2 * D + n) * D + k] = (bf16)f2bf(P.kv_w[(size_t)k * (2 * D + NH) + 2 * D + n] * P.kv_g[k]); }
    unsigned* wz = (unsigned*)(wkv + (size_t)(2 * D + NH) * D);
    for (int e = gt; e < (NKV - 2 * D - NH) * D / 2; e += NGT) wz[e] = 0u;
}
__device__ __forceinline__ void thin_phase(const Frame& F, const float* xin, bf16* X, const bf16* hb, const float* gpost, float w, float* rs, float* outf, int flags) {
    constexpr int R = 4;
    const int gw = F.vcu * NWAVES + F.wave, NGW = F.G * NWAVES, lane = F.lane;
    const bool has_h = flags & 1, src32 = flags & 2, fin = flags & 4;
    f32x4 gp[4];
#pragma unroll
    for (int j = 0; j < 4; ++j) gp[j] = has_h ? *(const GAS f32x4*)(gpost + 4 * lane + 256 * j) * w : (f32x4){0.f, 0.f, 0.f, 0.f};
    for (long base = (long)gw * R; base < M; base += (long)NGW * R) {
        f32x4 xv[R][4]; v2u hv[R][4];
        if (src32) {
#pragma unroll
            for (int r = 0; r < R; ++r)
#pragma unroll
                for (int j = 0; j < 4; ++j) xv[r][j] = *(const GAS f32x4*)(xin + (size_t)(base + r) * D + 4 * lane + 256 * j);
        } else {
#pragma unroll
            for (int r = 0; r < R; ++r)
#pragma unroll
                for (int j = 0; j < 4; ++j) { const v2u t = *(const GAS v2u*)(X + (size_t)(base + r) * D + 4 * lane + 256 * j); xv[r][j] = (f32x4){bflo(t.x), bfhi(t.x), bflo(t.y), bfhi(t.y)}; }
        }
        if (has_h) {
#pragma unroll
            for (int r = 0; r < R; ++r)
#pragma unroll
                for (int j = 0; j < 4; ++j) hv[r][j] = *(const GAS v2u*)(hb + (size_t)(base + r) * D + 4 * lane + 256 * j);
        }
#pragma unroll
        for (int r = 0; r < R; ++r) {
            if (has_h) {
                f32x4 h[4]; float ss = 0.f;
#pragma unroll
                for (int j = 0; j < 4; ++j) { h[j] = (f32x4){bflo(hv[r][j].x), bfhi(hv[r][j].x), bflo(hv[r][j].y), bfhi(hv[r][j].y)}; ss += (h[j].x * h[j].x + h[j].y * h[j].y) + (h[j].z * h[j].z + h[j].w * h[j].w); }
                const float rh = 1.0f / sqrtf(wave_sum(ss) * (1.0f / D) + RMS_EPS);
#pragma unroll
                for (int j = 0; j < 4; ++j) xv[r][j] += h[j] * rh * gp[j];
            }
            if (fin) {
#pragma unroll
                for (int j = 0; j < 4; ++j) *(GAS f32x4*)(outf + (size_t)(base + r) * D + 4 * lane + 256 * j) = xv[r][j];
            } else {
                float s2 = 0.f;
#pragma unroll
                for (int j = 0; j < 4; ++j) s2 += (xv[r][j].x * xv[r][j].x + xv[r][j].y * xv[r][j].y) + (xv[r][j].z * xv[r][j].z + xv[r][j].w * xv[r][j].w);
                const float r2 = 1.0f / sqrtf(wave_sum(s2) * (1.0f / D) + RMS_EPS);
                if (lane == 0) rs[base + r] = r2;
#pragma unroll
                for (int j = 0; j < 4; ++j) { v2u o; o.x = pk2(xv[r][j].x, xv[r][j].y); o.y = pk2(xv[r][j].z, xv[r][j].w); *(GAS v2u*)(X + (size_t)(base + r) * D + 4 * lane + 256 * j) = o; }
            }
        }
    }
}
__device__ __forceinline__ void conv_phase(const Frame& F, const bf16* U, const bf16* Bg, const float* ck, bf16* Z) {
    constexpr int RB = 16;
    const int gw = F.vcu * NWAVES + F.wave, NGW = F.G * NWAVES, lane = F.lane;
    for (int it = gw; it < (M / RB) * 2; it += NGW) {
        const int r0 = (it >> 1) * RB, c0 = (it & 1) * 512 + lane * 8;
        float kw[3][8];
#pragma unroll
        for (int wq = 0; wq < 3; ++wq) { const f32x4 a = *(const f32x4*)(ck + wq * D + c0), b = *(const f32x4*)(ck + wq * D + c0 + 4);
            kw[wq][0] = a.x; kw[wq][1] = a.y; kw[wq][2] = a.z; kw[wq][3] = a.w; kw[wq][4] = b.x; kw[wq][5] = b.y; kw[wq][6] = b.z; kw[wq][7] = b.w; }
        const bool first = (r0 % SEQ) == 0;
        v4u u2 = (v4u){0u, 0u, 0u, 0u}, u1 = u2;
        if (!first) { u2 = *(const GAS v4u*)(U + (size_t)(r0 - 2) * D + c0); u1 = *(const GAS v4u*)(U + (size_t)(r0 - 1) * D + c0); }
#pragma unroll 4
        for (int r = 0; r < RB; ++r) {
            const v4u u0 = *(const GAS v4u*)(U + (size_t)(r0 + r) * D + c0), bg = *(const GAS v4u*)(Bg + (size_t)(r0 + r) * D + c0);
            v4u o;
#pragma unroll
            for (int e = 0; e < 4; ++e) {
                const float ylo = kw[0][2 * e] * bflo(u2[e]) + kw[1][2 * e] * bflo(u1[e]) + kw[2][2 * e] * bflo(u0[e]);
                const float yhi = kw[0][2 * e + 1] * bfhi(u2[e]) + kw[1][2 * e + 1] * bfhi(u1[e]) + kw[2][2 * e + 1] * bfhi(u0[e]);
                o[e] = pk2(ylo * bflo(bg[e]), yhi * bfhi(bg[e]));
            }
            *(GAS v4u*)(Z + (size_t)(r0 + r) * D + c0) = o;
            u2 = u1; u1 = u0;
        }
    }
}
__device__ __forceinline__ void cumsum_phase(const Frame& F, const float* FL, const float* fb, float* C2) {
    if (F.wave != 0) return;
    for (int bh = F.vcu; bh < BATCH * NH; bh += F.G) {
        const int b = bh / NH, h = bh % NH; const float bias = fb[h]; float carry = 0.f;
        for (int j = 0; j < SEQ / 64; ++j) {
            const int t = 64 * j + F.lane; const float xl = FL[((size_t)b * SEQ + t) * NH + h] + bias;
            float v = fminf(xl, 0.f) - log1pf(expf(-fabsf(xl)));
#pragma unroll
            for (int o = 1; o < 64; o <<= 1) { const float y = __shfl_up(v, o); if (F.lane >= o) v += y; }
            v += carry; C2[(size_t)bh * SEQ + t] = v * 1.4426950408889634f; carry = __shfl(v, 63);
        }
    }
}

#ifndef PROBE
#define PROBE 0
#endif
struct Args { const float* in[19]; float* out; unsigned char* ws; };
__global__ void __launch_bounds__(NWAVES * 64, 2) yoco_fwd(Args args) {
    extern __shared__ __attribute__((aligned(16))) unsigned char lds[];
    cg::grid_group grid = cg::this_grid();
    Frame F;
    F.lds = (LAS unsigned char*)lds; F.tid = threadIdx.x; F.lane = F.tid & 63; F.wave = __builtin_amdgcn_readfirstlane(F.tid >> 6);
    F.G = gridDim.x; { const int bx = blockIdx.x; F.vcu = (F.G % 8 == 0) ? (bx % 8) * (F.G / 8) + bx / 8 : bx; }
    volatile LAS unsigned* const MISC = (volatile LAS unsigned*)(F.lds + RING_BYTES + 512);
    if (F.tid < 32) MISC[F.tid] = 0u;
    __syncthreads();
    const XcdBarrier xbar = xcd_barrier_post((unsigned*)(args.ws + WS_CTL) + CW_BAR, MISC + 8);
    Ptrs P;
    P.x = args.in[0]; P.ffn1_pre_g = args.in[1]; P.ffn1_post_g = args.in[2]; P.ffn1_w_in = args.in[3]; P.ffn1_w_out = args.in[4]; P.mix_pre_g = args.in[5]; P.mix_post_g = args.in[6];
    P.ffn2_pre_g = args.in[7]; P.ffn2_post_g = args.in[8]; P.ffn2_w_in = args.in[9]; P.ffn2_w_out = args.in[10]; P.conv_w_in = args.in[11]; P.conv_k = args.in[12]; P.conv_w_out = args.in[13];
    P.kv_g = args.in[14]; P.kv_w = args.in[15]; P.forget_b = args.in[16]; P.attn_w_qg = args.in[17]; P.attn_w_o = args.in[18];
    float* out = args.out; unsigned char* ws = args.ws;
    bf16* const XH = (bf16*)(ws + WS_XH); bf16* const RH = (bf16*)(ws + WS_R);
    bf16* const Ub = RH; bf16* const Bgb = RH + (size_t)M * D; bf16* const Zb = RH + 2 * (size_t)M * D;
    bf16* const Qb = RH; bf16* const Gtb = RH + (size_t)M * D; bf16* const Ob = RH + 2 * (size_t)M * D;
    bf16* const Kb = (bf16*)(ws + WS_K); bf16* const Vb = (bf16*)(ws + WS_V);
    bf16* const WFI = (bf16*)(ws + WS_WFI); bf16* const WFO = (bf16*)(ws + WS_WFO);
    float* const FL = (float*)(ws + WS_FL); float* const C2 = (float*)(ws + WS_C2); float* const RS = (float*)(ws + WS_RS);
    bf16* const HS = (bf16*)out;

    enum { K_GEMM = 0, K_THIN = 1, K_CONV = 2, K_ATT = 3 };
    struct PhaseDesc { unsigned long long p0, p1, p2, p3; int kind, mode, N, K, ldc, flags; float w; int sync; };
    LAS unsigned* const tabw = (LAS unsigned*)(F.lds + RING_BYTES + 1024);
#define TAB_PUT(i, d) do { LAS unsigned* t_ = tabw + 16 * (i); t_[0] = (unsigned)(d).p0; t_[1] = (unsigned)((d).p0 >> 32); t_[2] = (unsigned)(d).p1; t_[3] = (unsigned)((d).p1 >> 32); t_[4] = (unsigned)(d).p2; t_[5] = (unsigned)((d).p2 >> 32); \
        t_[6] = (unsigned)(d).p3; t_[7] = (unsigned)((d).p3 >> 32); t_[8] = (unsigned)(d).kind; t_[9] = (unsigned)(d).mode; t_[10] = (unsigned)(d).N; t_[11] = (unsigned)(d).K; t_[12] = (unsigned)(d).ldc; t_[13] = (unsigned)(d).flags; \
        t_[14] = __float_as_uint((d).w); t_[15] = (unsigned)(d).sync; } while (0)
    if (F.tid == 0) {
        int n_ = 0;
#define PD_GEMM(i, A_, B_, N_, K_, mode_, O0_, O1_, ldc_, sync_) do { PhaseDesc d; d.p0 = (unsigned long long)(A_); d.p1 = (unsigned long long)(B_); d.p2 = (unsigned long long)(O0_); d.p3 = (unsigned long long)(O1_); \
        d.kind = K_GEMM; d.mode = (mode_); d.N = (N_); d.K = (K_); d.ldc = (ldc_); d.flags = 0; d.w = 0.f; d.sync = (sync_); TAB_PUT(n_, d); ++n_; if (PROBE == 1) { d.sync = 1; TAB_PUT(n_, d); ++n_; } } while (0)
#define PD_THIN(i, hs_, g_, w_, flags_, cums_, sync_) do { PhaseDesc d; d.p0 = (unsigned long long)(hs_); d.p1 = (unsigned long long)(g_); d.p2 = 0; d.p3 = 0; \
        d.kind = K_THIN; d.mode = (cums_); d.N = 0; d.K = 0; d.ldc = 0; d.flags = (flags_); d.w = (w_); d.sync = (sync_); TAB_PUT(n_, d); ++n_; } while (0)
#define PD_OTHER(i, kind_) do { PhaseDesc d; d.p0 = 0; d.p1 = 0; d.p2 = 0; d.p3 = 0; d.kind = (kind_); d.mode = 0; d.N = 0; d.K = 0; d.ldc = 0; d.flags = 0; d.w = 0.f; d.sync = 1; TAB_PUT(n_, d); ++n_; if (PROBE == 2 && (kind_) == K_ATT) { TAB_PUT(n_, d); ++n_; } } while (0)
#define PD_UP(i, j)   PD_GEMM(i, XH, WFI + (size_t)(j) * FF2 * D, FF2, D, pg8::EM_SWIGLU, RH, 0, FF, 1)
#define PD_DOWN(i, j, hs) PD_GEMM(i, RH, WFO + (size_t)(j) * D * FF, D, FF, pg8::EM_PLAIN, hs, 0, D, 1)
        PD_UP(0, 0); PD_DOWN(1, 0, HS);
        PD_THIN(2, HS, P.ffn1_post_g, 0.5f, 1, 0, 1);
        PD_GEMM(3, XH, ws + WS_WCI, 3 * D, D, pg8::EM_CONV, Ub, Bgb, D, 1);
        PD_OTHER(4, K_CONV);
        PD_GEMM(5, Zb, ws + WS_WCO, D, D, pg8::EM_PLAIN, HS, 0, D, 1);
        PD_THIN(6, HS, P.mix_post_g, 1.0f, 1, 0, 1);
        PD_UP(7, 1); PD_DOWN(8, 1, HS);
        PD_THIN(9, HS, P.ffn2_post_g, 0.5f, 1, 0, 1);
        PD_GEMM(10, XH, ws + WS_WKV, NKV, D, pg8::EM_KV, Kb, Vb, D, 0);
        PD_UP(11, 2); PD_DOWN(12, 2, HS);
        PD_THIN(13, HS, P.ffn1_post_g + D, 0.5f, 1, 1, 1);
        PD_GEMM(14, XH, ws + WS_WQG, 2 * D, D, pg8::EM_QG, Qb, Gtb, D, 1);
        PD_OTHER(15, K_ATT);
        PD_GEMM(16, Ob, ws + WS_WO, D, D, pg8::EM_PLAIN, HS, 0, D, 1);
        PD_THIN(17, HS, P.mix_post_g + D, 1.0f, 1, 0, 1);
        PD_UP(18, 3); PD_DOWN(19, 3, Kb);
        PD_THIN(20, Kb, P.ffn2_post_g + D, 0.5f, 5, 0, 0);
        tabw[16 * 63] = (unsigned)n_;
#undef PD_GEMM
#undef PD_THIN
#undef PD_OTHER
#undef PD_UP
#undef PD_DOWN
    }
    convert_weights(F, P, ws);
#if PROBE == 3
    convert_weights(F, P, ws);
#endif
    thin_phase(F, P.x, XH, nullptr, nullptr, 0.f, RS, nullptr, 2);
    const float* const conv_k = P.conv_k; const float* const forget_b = P.forget_b;
    grid.sync();
#define RFL(v) __builtin_amdgcn_readfirstlane((int)(v))
#define RFL64(v) (((unsigned long long)(unsigned)RFL((v) >> 32) << 32) | (unsigned long long)(unsigned)RFL((v) & 0xffffffffull))
    const int wave0 = F.wave, bx0 = (int)blockIdx.x, vcu0 = F.vcu;
    const int NPH = RFL(tabw[16 * 63]);
    for (int ph = 0; ph < NPH; ++ph) {
        int tid, bx = bx0, vcu = vcu0; asm volatile("v_mbcnt_lo_u32_b32 %0, -1, 0\n\tv_mbcnt_hi_u32_b32 %0, -1, %0" : "=v"(tid)); asm volatile("" : "+s"(bx), "+s"(vcu));
        tid += wave0 * 64;
        F.tid = tid; F.lane = tid & 63; F.wave = __builtin_amdgcn_readfirstlane(tid >> 6); F.vcu = vcu;
        const LAS unsigned* const td = tabw + 16 * ph;
#define TD32(k) RFL(td[k])
#define TD64(k) (((unsigned long long)(unsigned)TD32((k) + 1) << 32) | (unsigned long long)(unsigned)TD32(k))
        const int kind = TD32(8);
        if (kind == K_GEMM) {
            pg8::Gemm g{(const bf16*)TD64(0), (const bf16*)TD64(2), M, TD32(10), TD32(11)};
            pg8::EpiMulti E{TD32(9), (pg8::EpiMulti::gbf)TD64(4), (pg8::EpiMulti::gbf)TD64(6), (pg8::EpiMulti::gf32)FL, TD32(12), attn_body::C2, (const GAS float*)RS};
            pg8::StaticOrder S; S.init(g.M, g.N, F.G, bx);
            pg8::gemm_phase<pg8::EpiMulti, pg8::StaticOrder, true, true>(F.lds, g, S, E, tid);
        } else if (kind == K_THIN) {
            if (TD32(9)) cumsum_phase(F, FL, forget_b, C2);
            thin_phase(F, nullptr, XH, (const bf16*)TD64(0), (const float*)TD64(2), __uint_as_float((unsigned)TD32(14)), RS, out, TD32(13));
        } else if (kind == K_CONV) {
            conv_phase(F, Ub, Bgb, conv_k, Zb);
        } else {
            const attn_body::AttnTensors AT{(const attn_body::bf16*)Qb, (const attn_body::bf16*)Kb, (const attn_body::bf16*)Vb, (attn_body::bf16*)Ob, (const attn_body::bf16*)Gtb, C2};
            const attn_body::StaticOrder S((int)F.G, bx);
            attn_body::attn_phase<attn_body::StaticOrder>((char*)lds, AT, S, tid);
        }
        asm volatile("" ::: "memory");
        if (TD32(15)) xcd_barrier(xbar);
#if PROBE == 4
        if (TD32(15)) xcd_barrier(xbar);
#endif
    }
#undef TD32
#undef TD64
#undef RFL
#undef RFL64
}

extern "C" void kernel_launch(void* const* d_in, const int* in_sizes, int n_in, void* d_out, int out_size, void* d_ws, size_t ws_size, hipStream_t stream) {
    static int grid = 0;
    if (grid == 0) {
        if (n_in != 19 || in_sizes[0] != M * D || out_size != M * D || ws_size < WS_END) { fprintf(stderr, "kernel_launch: unexpected shapes (n_in %d, in0 %d, out %d, ws %zu); nothing launched\n", n_in, n_in > 0 ? in_sizes[0] : -1, out_size, ws_size); grid = -1; return; }
        int dev = 0, cus = 0, per_cu = 0;
        if (hipGetDevice(&dev) != hipSuccess || hipDeviceGetAttribute(&cus, hipDeviceAttributeMultiprocessorCount, dev) != hipSuccess) { fprintf(stderr, "kernel_launch: device query failed\n"); grid = -1; return; }
        if (hipFuncSetAttribute((const void*)yoco_fwd, hipFuncAttributeMaxDynamicSharedMemorySize, LDS_BYTES) != hipSuccess) { fprintf(stderr, "kernel_launch: hipFuncSetAttribute failed\n"); grid = -1; return; }
        if (hipOccupancyMaxActiveBlocksPerMultiprocessor(&per_cu, (const void*)yoco_fwd, NWAVES * 64, LDS_BYTES) != hipSuccess || per_cu < 1) { fprintf(stderr, "kernel_launch: occupancy query says %d blocks per CU\n", per_cu); per_cu = 1; }
        (void)hipGetLastError();
        grid = cus * per_cu;
    }
    if (grid < 0) return;
    if (hipMemsetAsync((char*)d_ws + WS_CTL, 0, CTL_ZERO_BYTES, stream) != hipSuccess) { fprintf(stderr, "kernel_launch: hipMemsetAsync of the control words failed; nothing launched\n"); return; }
    Args a{};
    for (int i = 0; i < 19; ++i) a.in[i] = (const float*)d_in[i];
    a.out = (float*)d_out; a.ws = (unsigned char*)d_ws;
    void* kargs[] = {&a};
    const hipError_t e = hipLaunchCooperativeKernel((const void*)yoco_fwd, dim3(grid), dim3(NWAVES * 64), kargs, LDS_BYTES, stream);
    if (e != hipSuccess) fprintf(stderr, "kernel_launch: cooperative launch failed: %s (grid %d)\n", hipGetErrorString(e), grid);
}
```

```cpp
#include <hip/hip_runtime.h>
#include <hip/hip_cooperative_groups.h>
#include <cstdio>
#include <cstdint>
namespace cg = cooperative_groups;
namespace pg8 {
#define PG8_LAS __attribute__((address_space(3)))
typedef unsigned short bf16_t;
typedef short bf16x8 __attribute__((ext_vector_type(8)));
typedef float f32x4 __attribute__((ext_vector_type(4)));
typedef unsigned u32x4 __attribute__((ext_vector_type(4)));
constexpr int BM = 256, BK = 64, HALF = 128, HTB = HALF * BK * 2  , STAGE_BYTES = 8 * HTB, NXCD = 8, WGM = 8;

__host__ __device__ __forceinline__ int lds_byte(int r, int c) { const int st = (r >> 4) * 2 + (c >> 5), rr = r & 15, cc = c & 31, ob = rr * 64 + cc * 2; return st * 1024 + (ob ^ (((ob >> 9) & 1) << 5)); }
__host__ __device__ __forceinline__ void stage_rc(int b, int& R, int& C) { const int st = b / 1024, sb = b % 1024, swz = sb ^ (((sb >> 9) & 1) << 5); R = (st >> 1) * 16 + swz / 64; C = (st & 1) * 32 + (swz % 64) / 2; }
__host__ __device__ __forceinline__ int perm32(int rho) { const int n = rho >> 4, i = rho & 15; return 8 * (i >> 2) + 4 * n + (i & 3); }

struct Unit { int pm, pn; };
struct Gemm { const bf16_t* A; const bf16_t* Bt; int M, N, K; };

struct StaticOrder {
    int nM, nN, nwg, G, c;
    __host__ __device__ void init(int M, int N, int G_, int c_) { nM = M / BM; nN = N / BM; nwg = nM * nN; G = G_; c = c_; }
    __host__ __device__ bool next(int i, Unit& u) const {
        const long L = (long)i * G + c; if (L >= nwg) return false;
        int wgid = (int)L; { const int q = nwg / NXCD, r = nwg % NXCD, xcd = wgid % NXCD, off = wgid / NXCD; wgid = (xcd < r ? xcd * (q + 1) : r * (q + 1) + (xcd - r) * q) + off; }
        const int nig = WGM * nN, gid = wgid / nig, fm = gid * WGM, gsz = (nM - fm) < WGM ? (nM - fm) : WGM;
        u.pm = fm + ((wgid % nig) % gsz); u.pn = (wgid % nig) / gsz; return true;
    }
    __device__ __forceinline__ void a_ready(const Unit&) const {}
    __device__ __forceinline__ void done(const Unit&) const {}
};

__device__ __forceinline__ unsigned cvt_pk_bf16(float lo, float hi) { unsigned r; asm volatile("v_cvt_pk_bf16_f32 %0, %1, %2" : "=v"(r) : "v"(lo), "v"(hi)); return r; }
typedef float f32x2 __attribute__((ext_vector_type(2)));
template <class Epi, class Sched, bool ALIGN_EPI = false, bool SP2 = false>
__device__ __forceinline__ void gemm_phase(PG8_LAS unsigned char* lds, const Gemm g, const Sched& S, const Epi& E, const int tid) {
    const int wid = __builtin_amdgcn_readfirstlane(tid >> 6), lane = tid & 63, wr = wid >> 2, wc = wid & 3, fr = lane & 15, fq = lane >> 4;
    const int K = g.K, nt = K / BK;
    unsigned voffA[2], voffB[2];
#pragma unroll
    for (int i = 0; i < 2; ++i) { int R, C; stage_rc(tid * 16 + i * 8192, R, C); const int Rb = Epi::PERM ? ((R & ~31) + perm32(R & 31)) : R;
        voffA[i] = (unsigned)(R * K + C) * 2u; voffB[i] = (unsigned)(Rb * K + C) * 2u; }
    const size_t kstep = (size_t)(BK * 2);
    const size_t hstep = (size_t)HALF * K * 2;
    const size_t tstep = 2 * hstep;
    const unsigned ldsw = (unsigned)wid * 1024u;
    const int aoff = lds_byte(wr * 64 + fr, fq * 8), boff = lds_byte(wc * 32 + fr, fq * 8);
#define PG8_SA(b, h) (((b) * 2 + (h)) * HTB)
#define PG8_SB(b, h) ((4 + (b) * 2 + (h)) * HTB)
#define PG8_STAGE(bufoff, gbase, voff) do { _Pragma("unroll") for (int _i = 0; _i < 2; ++_i) \
        __builtin_amdgcn_global_load_lds((const unsigned*)((const char*)(gbase) + (voff)[_i]), (PG8_LAS unsigned*)(lds + (bufoff) + ldsw + _i * 8192), 16, 0, 0); } while (0)
#define PG8_LDA(dst, b, h) do { _Pragma("unroll") for (int m = 0; m < 4; ++m) _Pragma("unroll") for (int k = 0; k < 2; ++k) dst[m][k] = *(const PG8_LAS bf16x8*)(lds + PG8_SA(b, h) + aoff + m * 2048 + k * 1024); } while (0)
#define PG8_LDB(dst, b, h) do { _Pragma("unroll") for (int n = 0; n < 2; ++n) _Pragma("unroll") for (int k = 0; k < 2; ++k) dst[n][k] = *(const PG8_LAS bf16x8*)(lds + PG8_SB(b, h) + boff + n * 2048 + k * 1024); } while (0)
#define PG8_MMA(ai, bj, At, Bt) do { __builtin_amdgcn_s_setprio(1); _Pragma("unroll") for (int m = 0; m < 4; ++m) _Pragma("unroll") for (int n = 0; n < 2; ++n) _Pragma("unroll") for (int k = 0; k < 2; ++k) \
        acc[ai][bj][m][n] = __builtin_amdgcn_mfma_f32_16x16x32_bf16(Bt[n][k], At[m][k], acc[ai][bj][m][n], 0, 0, 0); __builtin_amdgcn_s_setprio(0); } while (0)
#define PG8_WAIT_V(n) asm volatile("s_waitcnt vmcnt(" #n ")" ::: "memory")
#define PG8_WAIT_L(n) asm volatile("s_waitcnt lgkmcnt(" #n ")" ::: "memory")
#define PG8_BAR __builtin_amdgcn_s_barrier()
#define PG8_SCHED __builtin_amdgcn_sched_barrier(0)
    Unit cur, nxt; int ui = 0;
    if (!S.next(0, cur)) return;
    f32x4 acc[2][2][4][2];
#pragma unroll
    for (int a = 0; a < 2; ++a)
#pragma unroll
        for (int b = 0; b < 2; ++b)
#pragma unroll
            for (int m = 0; m < 4; ++m)
#pragma unroll
                for (int n = 0; n < 2; ++n) acc[a][b][m][n] = (f32x4){0.f, 0.f, 0.f, 0.f};
    bf16x8 At[4][2], B0[2][2], B1[2][2];
    const char* cA = (const char*)g.A + (size_t)cur.pm * tstep; const char* cB = (const char*)g.Bt + (size_t)cur.pn * tstep;
    S.a_ready(cur);
    if constexpr (SP2) {
        PG8_STAGE(PG8_SB(0, 0), cB, voffB); PG8_STAGE(PG8_SB(0, 1), cB + hstep, voffB); PG8_STAGE(PG8_SA(0, 0), cA, voffA); PG8_STAGE(PG8_SA(0, 1), cA + hstep, voffA);
        if (wr == 1) PG8_BAR;
        PG8_WAIT_V(2); PG8_BAR;
        PG8_STAGE(PG8_SB(1, 0), cB + kstep, voffB); PG8_STAGE(PG8_SA(1, 0), cA + kstep, voffA); PG8_STAGE(PG8_SB(1, 1), cB + hstep + kstep, voffB);
        PG8_WAIT_V(6); PG8_BAR;
    } else {
        PG8_STAGE(PG8_SB(0, 0), cB, voffB); PG8_STAGE(PG8_SA(0, 0), cA, voffA); PG8_STAGE(PG8_SB(0, 1), cB + hstep, voffB); PG8_STAGE(PG8_SA(0, 1), cA + hstep, voffA);
        if (wr == 1) PG8_BAR;
        PG8_WAIT_V(4); PG8_BAR;
        PG8_STAGE(PG8_SB(1, 0), cB + kstep, voffB); PG8_STAGE(PG8_SA(1, 0), cA + kstep, voffA); PG8_STAGE(PG8_SB(1, 1), cB + hstep + kstep, voffB);
        PG8_WAIT_V(6); PG8_BAR;
    }
    for (;;) {
        const bool has_next = S.next(ui + 1, nxt);
        const char* nA = has_next ? (const char*)g.A + (size_t)nxt.pm * tstep : cA; const char* nB = has_next ? (const char*)g.Bt + (size_t)nxt.pn * tstep : cB;
        for (int t = 0; t < nt; t += 2) {
            const bool last = (t == nt - 2);
            const char* a1 = cA + (size_t)(t + 1) * kstep;
            const char* a2 = last ? nA : cA + (size_t)(t + 2) * kstep; const char* b2 = last ? nB : cB + (size_t)(t + 2) * kstep;
            const char* a3 = a2 + kstep; const char* b3 = b2 + kstep;
            if (last && has_next) S.a_ready(nxt);
            if constexpr (SP2) {
            PG8_LDB(B0, 0, 0); PG8_LDB(B1, 0, 1); PG8_SCHED; PG8_LDA(At, 0, 0); PG8_STAGE(PG8_SA(1, 1), a1 + hstep, voffA);
            PG8_WAIT_V(8); PG8_WAIT_L(0); PG8_BAR; PG8_MMA(0, 0, At, B0); PG8_MMA(0, 1, At, B1); PG8_BAR; PG8_SCHED;
            PG8_LDA(At, 0, 1); PG8_STAGE(PG8_SB(0, 0), b2, voffB); PG8_STAGE(PG8_SB(0, 1), b2 + hstep, voffB); PG8_STAGE(PG8_SA(0, 0), a2, voffA);
            PG8_WAIT_V(8); PG8_WAIT_L(0); PG8_BAR; PG8_MMA(1, 0, At, B0); PG8_MMA(1, 1, At, B1); PG8_BAR; PG8_SCHED;
            PG8_LDB(B0, 1, 0); PG8_LDB(B1, 1, 1); PG8_SCHED; PG8_LDA(At, 1, 0); PG8_STAGE(PG8_SA(0, 1), a2 + hstep, voffA);
            PG8_WAIT_V(8); PG8_WAIT_L(0); PG8_BAR; PG8_MMA(0, 0, At, B0); PG8_MMA(0, 1, At, B1); PG8_BAR; PG8_SCHED;
            PG8_LDA(At, 1, 1); PG8_STAGE(PG8_SB(1, 0), b3, voffB); PG8_STAGE(PG8_SB(1, 1), b3 + hstep, voffB); PG8_STAGE(PG8_SA(1, 0), a3, voffA);
            PG8_WAIT_V(8); PG8_WAIT_L(0); PG8_BAR; PG8_MMA(1, 0, At, B0); PG8_MMA(1, 1, At, B1); PG8_BAR; PG8_SCHED;
            } else {
            PG8_LDB(B0, 0, 0); PG8_SCHED; PG8_LDA(At, 0, 0); PG8_STAGE(PG8_SA(1, 1), a1 + hstep, voffA);
            PG8_WAIT_L(8); PG8_BAR; PG8_WAIT_L(0); PG8_MMA(0, 0, At, B0); PG8_BAR; PG8_SCHED;
            PG8_LDB(B1, 0, 1); PG8_STAGE(PG8_SB(0, 0), b2, voffB);
            PG8_BAR; PG8_WAIT_L(0); PG8_MMA(0, 1, At, B1); PG8_BAR;
            PG8_LDA(At, 0, 1); PG8_STAGE(PG8_SA(0, 0), a2, voffA);
            PG8_BAR; PG8_WAIT_L(0); PG8_MMA(1, 0, At, B0); PG8_BAR; PG8_SCHED;
            PG8_STAGE(PG8_SB(0, 1), b2 + hstep, voffB);
            PG8_WAIT_V(6); PG8_BAR; PG8_MMA(1, 1, At, B1); PG8_BAR;
            PG8_LDB(B0, 1, 0); PG8_SCHED; PG8_LDA(At, 1, 0); PG8_STAGE(PG8_SA(0, 1), a2 + hstep, voffA);
            PG8_WAIT_L(8); PG8_BAR; PG8_WAIT_L(0); PG8_MMA(0, 0, At, B0); PG8_BAR; PG8_SCHED;
            PG8_LDB(B1, 1, 1); PG8_STAGE(PG8_SB(1, 0), b3, voffB);
            PG8_BAR; PG8_WAIT_L(0); PG8_MMA(0, 1, At, B1); PG8_BAR;
            PG8_LDA(At, 1, 1); PG8_STAGE(PG8_SA(1, 0), a3, voffA);
            PG8_BAR; PG8_WAIT_L(0); PG8_MMA(1, 0, At, B0); PG8_BAR; PG8_SCHED;
            PG8_STAGE(PG8_SB(1, 1), b3 + hstep, voffB);
            PG8_WAIT_V(6); PG8_BAR; PG8_MMA(1, 1, At, B1); PG8_BAR;
            }
        }
        if constexpr (ALIGN_EPI) { if (wr == 0) PG8_BAR; }
        if constexpr (!Epi::AFTER_DRAIN) { E(acc, cur, wr, wc, fr, fq); S.done(cur); }
        if (!has_next) break;
#pragma unroll
        for (int a = 0; a < 2; ++a)
#pragma unroll
            for (int b = 0; b < 2; ++b)
#pragma unroll
                for (int m = 0; m < 4; ++m)
#pragma unroll
                    for (int n = 0; n < 2; ++n) acc[a][b][m][n] = (f32x4){0.f, 0.f, 0.f, 0.f};
        cur = nxt; cA = nA; cB = nB; ++ui;
        if constexpr (ALIGN_EPI) { if (wr == 1) PG8_BAR; }
    }
    PG8_WAIT_V(0);
    if constexpr (!ALIGN_EPI) { if (wr == 0) PG8_BAR; }
    PG8_BAR;
    if constexpr (Epi::AFTER_DRAIN) { E.fused(acc, cur, wr, wc, fr, fq, lds, wid, lane); S.done(cur); }
#undef PG8_SA
#undef PG8_SB
#undef PG8_STAGE
#undef PG8_LDA
#undef PG8_LDB
#undef PG8_MMA
#undef PG8_WAIT_V
#undef PG8_WAIT_L
#undef PG8_BAR
#undef PG8_SCHED
}
}
namespace pg8 {
enum { EM_PLAIN = 0, EM_SWIGLU = 1, EM_CONV = 2, EM_KV = 3, EM_QG = 4 };
struct EpiMulti {
    static constexpr bool PERM = true, AFTER_DRAIN = false;
    typedef __attribute__((address_space(1))) bf16_t* gbf; typedef __attribute__((address_space(1))) float* gf32;
    int mode; gbf O0; gbf O1; gf32 F; int ldc; float qscale; const __attribute__((address_space(1))) float* rs;
    __device__ __forceinline__ static void st8(gbf p, f32x4 v0, f32x4 v1) { u32x4 w; w.x = cvt_pk_bf16(v0[0], v0[1]); w.y = cvt_pk_bf16(v0[2], v0[3]); w.z = cvt_pk_bf16(v1[0], v1[1]); w.w = cvt_pk_bf16(v1[2], v1[3]); *(__attribute__((address_space(1))) u32x4*)p = w; }
    __device__ __forceinline__ static f32x4 sigm(f32x4 g) { f32x4 r;
#pragma unroll
        for (int i = 0; i < 4; ++i) r[i] = __builtin_amdgcn_rcpf(1.0f + __builtin_amdgcn_exp2f(g[i] * -1.4426950408889634f)); return r; }
    __device__ __forceinline__ void operator()(const f32x4 (&acc)[2][2][4][2], const Unit& u, int wr, int wc, int fr, int fq) const {
        const int row0 = u.pm * BM + wr * 64 + fr, cl = wc * 32 + 8 * fq;
        float rv[2][4];
        if (mode != EM_PLAIN) {
#pragma unroll
            for (int ai = 0; ai < 2; ++ai)
#pragma unroll
                for (int m = 0; m < 4; ++m) rv[ai][m] = rs[row0 + ai * HALF + m * 16];
        }
        if (mode == EM_PLAIN) {
#pragma unroll
            for (int ai = 0; ai < 2; ++ai)
#pragma unroll
                for (int m = 0; m < 4; ++m) { gbf rowp = O0 + (size_t)(row0 + ai * HALF + m * 16) * ldc + u.pn * BM + cl;
#pragma unroll
                    for (int bj = 0; bj < 2; ++bj) st8(rowp + bj * HALF, acc[ai][bj][m][0], acc[ai][bj][m][1]); }
        } else if (mode == EM_SWIGLU) {
#pragma unroll
            for (int ai = 0; ai < 2; ++ai)
#pragma unroll
                for (int m = 0; m < 4; ++m) { gbf rowp = O0 + (size_t)(row0 + ai * HALF + m * 16) * ldc + u.pn * HALF + cl;
                    const float r = rv[ai][m]; const f32x4 g0 = acc[ai][0][m][0] * r, g1 = acc[ai][0][m][1] * r;
                    st8(rowp, g0 * sigm(g0) * (acc[ai][1][m][0] * r), g1 * sigm(g1) * (acc[ai][1][m][1] * r)); }
        } else if (mode == EM_CONV) {
            if (u.pn < 8) {
#pragma unroll
                for (int ai = 0; ai < 2; ++ai)
#pragma unroll
                    for (int m = 0; m < 4; ++m) { gbf rowp = O0 + (size_t)(row0 + ai * HALF + m * 16) * ldc + u.pn * HALF + cl;
                        const float r2 = rv[ai][m] * rv[ai][m]; st8(rowp, acc[ai][0][m][0] * acc[ai][1][m][0] * r2, acc[ai][0][m][1] * acc[ai][1][m][1] * r2); }
            } else {
#pragma unroll
                for (int ai = 0; ai < 2; ++ai)
#pragma unroll
                    for (int m = 0; m < 4; ++m) { gbf rowp = O1 + (size_t)(row0 + ai * HALF + m * 16) * ldc + (u.pn - 8) * BM + cl; const float r = rv[ai][m];
#pragma unroll
                        for (int bj = 0; bj < 2; ++bj) st8(rowp + bj * HALF, acc[ai][bj][m][0] * r, acc[ai][bj][m][1] * r); }
            }
        } else if (mode == EM_KV) {
            if (u.pn < 8) { gbf base = (u.pn < 4) ? O0 : O1; const int ct = (u.pn & 3) * BM + cl;
#pragma unroll
                for (int ai = 0; ai < 2; ++ai)
#pragma unroll
                    for (int m = 0; m < 4; ++m) { gbf rowp = base + (size_t)(row0 + ai * HALF + m * 16) * ldc + ct; const float r = rv[ai][m];
#pragma unroll
                        for (int bj = 0; bj < 2; ++bj) st8(rowp + bj * HALF, acc[ai][bj][m][0] * r, acc[ai][bj][m][1] * r); }
            } else if (wc == 0 && fq < 2) {
#pragma unroll
                for (int ai = 0; ai < 2; ++ai)
#pragma unroll
                    for (int m = 0; m < 4; ++m) { gf32 fp = F + (size_t)(row0 + ai * HALF + m * 16) * 16 + 8 * fq;
                        *(__attribute__((address_space(1))) f32x4*)fp = acc[ai][0][m][0] * rv[ai][m]; *(__attribute__((address_space(1))) f32x4*)(fp + 4) = acc[ai][0][m][1] * rv[ai][m]; }
            }
        } else {
            const bool isq = u.pn < 4; gbf base = isq ? O0 : O1; const int ct = (u.pn & 3) * BM + cl;
#pragma unroll
            for (int ai = 0; ai < 2; ++ai)
#pragma unroll
                for (int m = 0; m < 4; ++m) { gbf rowp = base + (size_t)(row0 + ai * HALF + m * 16) * ldc + ct;
#pragma unroll
                    for (int bj = 0; bj < 2; ++bj) { f32x4 v0 = acc[ai][bj][m][0] * rv[ai][m], v1 = acc[ai][bj][m][1] * rv[ai][m];
                        if (isq) { v0 = v0 * qscale; v1 = v1 * qscale; } else { v0 = sigm(v0); v1 = sigm(v1); }
                        st8(rowp + bj * HALF, v0, v1); } }
        }
    }
};
}
#ifndef PG8_SP2
#define PG8_SP2 true
#endif
#include <hip/hip_bf16.h>
#include <cmath>
namespace attn_body {
using bf16=__hip_bfloat16;
using bf16x8=__attribute__((ext_vector_type(8)))short;
using s16x4=__attribute__((ext_vector_type(4)))short;
using f32x16=__attribute__((ext_vector_type(16)))float;
using u32x4=__attribute__((ext_vector_type(4)))unsigned;
using f32x4_t=__attribute__((ext_vector_type(4)))float;
constexpr int BATCH=16,NHEAD=16,SEQ=2048,D=64,DM=NHEAD*D;
constexpr int NW=8,QBLK=32,QB=QBLK*NW,KVBLK=64,NQB=SEQ/QB;
constexpr int ATTN_PITCH=DM, ATTN_UNIT_ROWS=QB;
__device__ __forceinline__ int crow(int r,int hi){return (r&3)+8*(r>>2)+4*hi;}
#define SBAR() __builtin_amdgcn_sched_barrier(0)
__device__ __forceinline__ void cmask(f32x16&p0,f32x16&p1,int jb,int qrel,int hi){
  const float NEG=-INFINITY; int kb=64*jb+4*hi;
  #pragma unroll
  for(int r=0;r<16;++r){int kv=kb+(r&3)+8*(r>>2); if(kv>qrel)p0[r]=NEG; if(kv+32>qrel)p1[r]=NEG;}
}

constexpr int NSLOT=3, SLOTB=8192;
constexpr int LDS_K=0, LDS_V=NSLOT*SLOTB, LDS_WS=2*NSLOT*SLOTB, LDS_OST=LDS_WS+NW*64*4, LDS_CT=LDS_OST+NW*4096, LDS_BYTES=LDS_CT+SEQ*4;
constexpr float C2=0.125f*1.4426950408889634f;
__device__ __forceinline__ void glds16(const void*gsrc,unsigned lds_dst){unsigned keep;
  asm volatile("s_mov_b32 %0, m0\n\ts_mov_b32 m0, %2\n\ts_nop 0\n\tglobal_load_lds_dwordx4 %1, off\n\ts_mov_b32 m0, %0":"=&s"(keep):"v"(gsrc),"s"(lds_dst):"memory");}
__device__ __forceinline__ float max3f(float a,float b,float c){float r;asm("v_max3_f32 %0, %1, %2, %3":"=v"(r):"v"(a),"v"(b),"v"(c));return r;}
__device__ __forceinline__ float max2f(float a,float b){float r;asm("v_max_f32_e32 %0, %1, %2":"=v"(r):"v"(a),"v"(b));return r;}
__device__ __forceinline__ float fadd_s(float a,float b){float r;asm("v_add_f32_e32 %0, %1, %2":"=v"(r):"v"(a),"v"(b));return r;}
__device__ __forceinline__ float fsub_s(float a,float b){float r;asm("v_sub_f32_e32 %0, %1, %2":"=v"(r):"v"(a),"v"(b));return r;}
typedef float f32x2_t __attribute__((ext_vector_type(2))); typedef __bf16 bf16x2_t __attribute__((ext_vector_type(2)));
__device__ __forceinline__ unsigned cvtpk_s(float lo,float hi){f32x2_t v={lo,hi};bf16x2_t b=__builtin_convertvector(v,bf16x2_t);return __builtin_bit_cast(unsigned,b);}
#define WAIT_BAR(N) asm volatile("s_waitcnt vmcnt(" #N ") lgkmcnt(0)\n\ts_barrier":::"memory")

__device__ __forceinline__ void qkt(f32x16&p0,f32x16&p1,const char*Kslot,const bf16x8*qr,int r32,int hi){
  const char*kb=Kslot+hi*1024+r32*16;
  #pragma unroll
  for(int d0=0;d0<4;++d0){
    const bf16x8 b0=*reinterpret_cast<const bf16x8*>(kb+d0*2048);
    const bf16x8 b1=*reinterpret_cast<const bf16x8*>(kb+d0*2048+512);
    p0=__builtin_amdgcn_mfma_f32_32x32x16_bf16(b0,qr[d0],p0,0,0,0);p1=__builtin_amdgcn_mfma_f32_32x32x16_bf16(b1,qr[d0],p1,0,0,0);}
}
typedef __attribute__((address_space(3))) const char* lds_cptr;
typedef short v4i16_t __attribute__((ext_vector_type(4)));
__device__ __forceinline__ void kload8(bf16x8*kf,lds_cptr kp){
  kf[0]=*(const __attribute__((address_space(3))) bf16x8*)(kp);      kf[1]=*(const __attribute__((address_space(3))) bf16x8*)(kp+512);
  kf[2]=*(const __attribute__((address_space(3))) bf16x8*)(kp+2048); kf[3]=*(const __attribute__((address_space(3))) bf16x8*)(kp+2560);
  kf[4]=*(const __attribute__((address_space(3))) bf16x8*)(kp+4096); kf[5]=*(const __attribute__((address_space(3))) bf16x8*)(kp+4608);
  kf[6]=*(const __attribute__((address_space(3))) bf16x8*)(kp+6144); kf[7]=*(const __attribute__((address_space(3))) bf16x8*)(kp+6656);
}
__device__ __forceinline__ void kload2(bf16x8*kf,lds_cptr kp,int j){ kf[2*j]=*(const __attribute__((address_space(3))) bf16x8*)(kp+j*2048); kf[2*j+1]=*(const __attribute__((address_space(3))) bf16x8*)(kp+j*2048+512); }
__device__ __forceinline__ s16x4 vtr(lds_cptr p){ return __builtin_bit_cast(s16x4,__builtin_amdgcn_ds_read_tr16_b64_v4i16((__attribute__((address_space(3))) v4i16_t*)p)); }
__device__ __forceinline__ float rowmax(const f32x16&p0,const f32x16&p1){
  float a=max3f(p0[0],p0[1],p1[0]),b=max3f(p0[2],p0[3],p1[1]);a=max3f(a,p1[2],p1[3]);
  #pragma unroll
  for(int r=4;r<16;r+=4){a=max3f(a,p0[r],p0[r+1]);b=max3f(b,p0[r+2],p0[r+3]);a=max3f(a,p1[r],p1[r+1]);b=max3f(b,p1[r+2],p1[r+3]);}
  const float m=max2f(a,b);
  auto rr=__builtin_amdgcn_permlane32_swap(__float_as_uint(m),__float_as_uint(m),false,false);
  return max2f(__uint_as_float(rr[0]),__uint_as_float(rr[1]));
}
__device__ __forceinline__ void pv(f32x16*o,int vb,bf16x8 pa0,bf16x8 pa1,bf16x8 pa2,bf16x8 pa3){
  #pragma unroll
  for(int d0=0;d0<2;++d0){s16x4 lo[4],hi[4];
    #pragma unroll
    for(int ks=0;ks<4;++ks){
      asm volatile("ds_read_b64_tr_b16 %0,%1 offset:%c2":"=&v"(lo[ks]):"v"(vb),"i"(d0*4096+ks*1024):"memory");
      asm volatile("ds_read_b64_tr_b16 %0,%1 offset:%c2":"=&v"(hi[ks]):"v"(vb),"i"(d0*4096+ks*1024+512):"memory");}
    asm volatile("s_waitcnt lgkmcnt(0)":::"memory");SBAR();
    #define PK(k) (bf16x8){lo[k][0],lo[k][1],lo[k][2],lo[k][3],hi[k][0],hi[k][1],hi[k][2],hi[k][3]}
    o[d0]=__builtin_amdgcn_mfma_f32_32x32x16_bf16(pa0,PK(0),o[d0],0,0,0);
    o[d0]=__builtin_amdgcn_mfma_f32_32x32x16_bf16(pa1,PK(1),o[d0],0,0,0);
    o[d0]=__builtin_amdgcn_mfma_f32_32x32x16_bf16(pa2,PK(2),o[d0],0,0,0);
    o[d0]=__builtin_amdgcn_mfma_f32_32x32x16_bf16(pa3,PK(3),o[d0],0,0,0);
    #undef PK
  }
}

#ifndef ATTN_STORE16
#define ATTN_STORE16(p,v) (*(u32x4*)(p)=(v))
#endif
template<int THRL> __device__ __forceinline__ void attn_unit(int b,int h,int qb,const bf16*Q,const bf16*__restrict__ K,const bf16*__restrict__ V,bf16*O,const bf16*__restrict__ GT,const float*__restrict__ C2T,bool load_ct,char*shm,const int tid){
  const int lane=tid&63,r32=lane&31,hi=lane>>5; const int wid=__builtin_amdgcn_readfirstlane(tid>>6);
  const long rowbase=(long)b*SEQ; const int q0=qb*QB;
  const bf16*Qw=Q+(rowbase+q0+wid*QBLK)*DM+h*D;
  const bf16*Kh=K+rowbase*DM+h*D,*Vh=V+rowbase*DM+h*D;
  const unsigned lds0=(unsigned)(uintptr_t)shm;
  float*wsf=(float*)(shm+LDS_WS)+wid*64;
  typedef __attribute__((address_space(3))) f32x4_t* lds_f4p;
  const float*c2row=C2T+((long)b*NHEAD+h)*SEQ;
  if(load_ct){ const f32x4_t cv=*reinterpret_cast<const f32x4_t*>(c2row+tid*4); asm volatile("s_waitcnt vmcnt(0)":::"memory"); *((lds_f4p)(shm+LDS_CT)+tid)=cv; }
  const float cq=c2row[qb*QB+wid*QBLK+r32];
  const __attribute__((address_space(3))) f32x4_t* ctab=(const __attribute__((address_space(3))) f32x4_t*)(shm+LDS_CT)+hi;
  #define CINIT(P0,P1,t) do{ const __attribute__((address_space(3))) f32x4_t* cp_=ctab+PT(t)*16; const float nm_=cq-mhat; \
    _Pragma("unroll") for(int j_=0;j_<4;++j_){ const f32x4_t a_=cp_[2*j_], b_=cp_[8+2*j_]; \
      P0[4*j_]=nm_-a_[0];P0[4*j_+1]=nm_-a_[1];P0[4*j_+2]=nm_-a_[2];P0[4*j_+3]=nm_-a_[3]; P1[4*j_]=nm_-b_[0];P1[4*j_+1]=nm_-b_[1];P1[4*j_+2]=nm_-b_[2];P1[4*j_+3]=nm_-b_[3]; } }while(0)
  #define CKLD(P0,P1,t) do{ const __attribute__((address_space(3))) f32x4_t* cp_=ctab+PT(t)*16; \
    _Pragma("unroll") for(int j_=0;j_<4;++j_){ const f32x4_t a_=cp_[2*j_], b_=cp_[8+2*j_]; \
      P0[4*j_]=a_[0];P0[4*j_+1]=a_[1];P0[4*j_+2]=a_[2];P0[4*j_+3]=a_[3]; P1[4*j_]=b_[0];P1[4*j_+1]=b_[1];P1[4*j_+2]=b_[2];P1[4*j_+3]=b_[3]; } }while(0)
  #define CSUB(P0,P1) do{ const float nm_=cq-mhat; _Pragma("unroll") for(int r_=0;r_<16;++r_){ P0[r_]=nm_-P0[r_]; } _Pragma("unroll") for(int r_=0;r_<16;++r_){ P1[r_]=nm_-P1[r_]; } }while(0)
  const bf16*ksrc=Kh+(long)lane*DM+wid*8;
  const bf16*vsrc=Vh+(long)(16*(wid&3)+(lane>>2))*DM+(wid>>2)*32+(lane&3)*8;
  const unsigned kdst=lds0+LDS_K+wid*1024, vdst=lds0+LDS_V+wid*1024;
  #define PT(t) (NT-1-(t))
  #define DMA_K(t,slot) glds16(ksrc+(long)PT(t)*KVBLK*DM,(unsigned)__builtin_amdgcn_readfirstlane(kdst+(slot)))
  #define DMA_V(t,slot) glds16(vsrc+(long)PT(t)*KVBLK*DM,(unsigned)__builtin_amdgcn_readfirstlane(vdst+(slot)))
  const int vb0=(int)(lds0+LDS_V)+((lane>>4)&1)*32+(lane&3)*8+(4*hi+((lane&15)>>2))*64;
  const char*Kbase=shm+LDS_K; bf16x8 kf[8];
  const lds_cptr shm3=(lds_cptr)shm; const lds_cptr kp0=shm3+LDS_K+hi*1024+r32*16; const lds_cptr vp0=shm3+LDS_V+((lane>>4)&1)*32+(lane&3)*8+(4*hi+((lane&15)>>2))*64;
  const int NT=(q0+QB)/KVBLK;
  DMA_K(0,0);DMA_V(0,0);DMA_K(1,SLOTB);
  bf16x8 qr[4];
  #pragma unroll
  for(int d0=0;d0<4;++d0)qr[d0]=*reinterpret_cast<const bf16x8*>(&Qw[(long)r32*DM+d0*16+hi*8]);
  float mhat=0.f,l_reg=0.f;f32x16 o[2];o[0]=f32x16{};o[1]=f32x16{};
  const int qrel=wid*QBLK+r32;
  #define CMASK(P0,P1,t) do{int jb_=3-(t); if(jb_>=0)cmask(P0,P1,jb_,qrel,hi);}while(0)
  bool resc=false;
  #define START(P0,P1) do{ const float rm=rowmax(P0,P1); resc=false; \
    { const float dl=max2f(rm,-64.0f);     \
      mhat=fadd_s(mhat,dl); \
      _Pragma("unroll") for(int r=0;r<16;++r){P0[r]=fsub_s(P0[r],dl);P1[r]=fsub_s(P1[r],dl);} \
      } \
    _Pragma("unroll") for(int r=0;r<16;++r)P0[r]=__builtin_amdgcn_exp2f(P0[r]); }while(0)
  #define RESC() do{ if(resc){ asm volatile("s_waitcnt lgkmcnt(0)":::"memory"); \
      _Pragma("unroll") for(int d_=0;d_<2;++d_) _Pragma("unroll") for(int r=0;r<16;++r)o[d_][r]*=wsf[crow(r,hi)]; } }while(0)
  f32x16 pA0,pA1,pB0,pB1;
  int sl_prev=0,sl_cur=0,sl_next=SLOTB;
  #define ROT() do{sl_prev=sl_cur;sl_cur=sl_next;sl_next=(sl_next==(NSLOT-1)*SLOTB)?0:sl_next+SLOTB;}while(0)
  DMA_K(2,2*SLOTB);
  WAIT_BAR(3);
  CINIT(pA0,pA1,0);
  qkt(pA0,pA1,Kbase,qr,r32,hi);asm volatile("s_nop 15\n\ts_nop 7":"+v"(pA0),"+v"(pA1));CMASK(pA0,pA1,0);
  START(pA0,pA1);
  CKLD(pB0,pB1,1);
  _Pragma("unroll") for(int r=0;r<16;++r)pA1[r]=__builtin_amdgcn_exp2f(pA1[r]);
  WAIT_BAR(0);
  DMA_K(3,0);DMA_V(1,SLOTB);
  ROT();
  kload8(kf,kp0+sl_cur);
  WAIT_BAR(2);
  s16x4 vlo[8],vhi[8]; u32x4 pw0,pw1,pw2,pw3;
  #define PKW(P,B) cvtpk_s(P[B],P[B+1])
  #define PAF(k) __builtin_bit_cast(bf16x8,pw##k)
  #define VFR(i) (bf16x8){vlo[i][0],vlo[i][1],vlo[i][2],vlo[i][3],vhi[i][0],vhi[i][1],vhi[i][2],vhi[i][3]}
  #define PIN(x) asm volatile("":"+v"(x))
  #define MX3(a,b,c) __builtin_fmaxf(__builtin_fmaxf((a),(b)),(c))
  #define GAPA(MF,A0,A1,A2,A3,W0,W1,PW) do{ MF; sacc+=A0; sacc+=A1; sacc+=A2; sacc+=A3; PIN(sacc); W0; W1; PIN(PW); SBAR(); }while(0)
  #define EX(v) __builtin_amdgcn_exp2f(v)
  #define GAPB(MF,X,B) do{ MF; X[B]=EX(X[B]); X[B+1]=EX(X[B+1]); X[B+2]=EX(X[B+2]); X[B+3]=EX(X[B+3]); PIN(X); SBAR(); }while(0)
  #define VRD(i) do{ vlo[i]=vtr(vp_+(((i)>>2)*4096+((i)&3)*1024)); vhi[i]=vtr(vp_+(((i)>>2)*4096+((i)&3)*1024+512)); }while(0)
  #define KRD(G,j) do{ if(G){ kload2(kf,kp0+sl_next,j); SBAR(); } }while(0)
  #define STEP(C0,C1,P0,P1,t,GK,GV,GL) do{ SBAR(); CSUB(C0,C1); SBAR(); \
    const lds_cptr vp_=vp0+sl_prev; \
    VRD(0); SBAR(); float sacc=(P0[0]+P0[1]); \
    GAPA(C0=__builtin_amdgcn_mfma_f32_32x32x16_bf16(kf[0],qr[0],C0,0,0,0), P0[2],P0[3],P0[4],P0[5],     pw0[0]=PKW(P0,0), pw0[1]=PKW(P0,2), pw0); \
    VRD(4); SBAR(); GAPA(C1=__builtin_amdgcn_mfma_f32_32x32x16_bf16(kf[1],qr[0],C1,0,0,0), P0[6],P0[7],P0[8],P0[9],     pw0[2]=PKW(P0,4), pw0[3]=PKW(P0,6), pw0); \
    VRD(1); SBAR(); GAPA(C0=__builtin_amdgcn_mfma_f32_32x32x16_bf16(kf[2],qr[1],C0,0,0,0),   P0[10],P0[11],P0[12],P0[13], pw1[0]=PKW(P0,8), pw1[1]=PKW(P0,10), pw1); \
    VRD(5); SBAR(); GAPA(C1=__builtin_amdgcn_mfma_f32_32x32x16_bf16(kf[3],qr[1],C1,0,0,0),   P0[14],P0[15],P1[0],P1[1],   pw1[2]=PKW(P0,12),pw1[3]=PKW(P0,14), pw1); \
    VRD(2); SBAR(); GAPA(C0=__builtin_amdgcn_mfma_f32_32x32x16_bf16(kf[4],qr[2],C0,0,0,0),   P1[2],P1[3],P1[4],P1[5],     pw2[0]=PKW(P1,0), pw2[1]=PKW(P1,2), pw2); \
    VRD(6); SBAR(); GAPA(C1=__builtin_amdgcn_mfma_f32_32x32x16_bf16(kf[5],qr[2],C1,0,0,0),   P1[6],P1[7],P1[8],P1[9],     pw2[2]=PKW(P1,4), pw2[3]=PKW(P1,6), pw2); \
    VRD(3); SBAR(); GAPA(C0=__builtin_amdgcn_mfma_f32_32x32x16_bf16(kf[6],qr[3],C0,0,0,0),   P1[10],P1[11],P1[12],P1[13], pw3[0]=PKW(P1,8), pw3[1]=PKW(P1,10), pw3); \
    VRD(7); SBAR(); GAPA(C1=__builtin_amdgcn_mfma_f32_32x32x16_bf16(kf[7],qr[3],C1,0,0,0),   P1[14],P1[15],0.f,0.f,       pw3[2]=PKW(P1,12),pw3[3]=PKW(P1,14), pw3); \
    l_reg+=sacc; \
    if(GK){DMA_K((t)+3,sl_cur);} if(GV){DMA_V((t)+1,sl_next);} \
    CMASK(C0,C1,t); \
    { float a=MX3(C0[0],C0[1],C1[0]),b=MX3(C0[2],C0[3],C1[1]); a=MX3(a,C1[2],C1[3]); \
      _Pragma("unroll") for(int r=4;r<16;r+=4){a=MX3(a,C0[r],C0[r+1]);b=MX3(b,C0[r+2],C0[r+3]);a=MX3(a,C1[r],C1[r+1]);b=MX3(b,C1[r+2],C1[r+3]);} \
      float rm=__builtin_fmaxf(a,b); { auto rr=__builtin_amdgcn_permlane32_swap(__float_as_uint(rm),__float_as_uint(rm),false,false); rm=__builtin_fmaxf(__uint_as_float(rr[0]),__uint_as_float(rr[1])); } \
      resc=false; \
      if(__builtin_expect(__any(rm>(float)THRL),0)){ const float dl=__builtin_fmaxf(rm,0.f); mhat+=dl; \
        _Pragma("unroll") for(int r=0;r<16;++r){C0[r]-=dl;C1[r]-=dl;} \
        const float f=__builtin_amdgcn_exp2f(-dl); l_reg*=f; if(hi==0)wsf[r32]=f; resc=true; } } \
    SBAR(); \
    if(GL){ CKLD(P0,P1,(t)+1); SBAR(); } \
    GAPB(o[0]=__builtin_amdgcn_mfma_f32_32x32x16_bf16(PAF(0),VFR(0),o[0],0,0,0), C0,0); \
    GAPB(o[1]=__builtin_amdgcn_mfma_f32_32x32x16_bf16(PAF(0),VFR(4),o[1],0,0,0), C0,4); \
    KRD(GL,0); GAPB(o[0]=__builtin_amdgcn_mfma_f32_32x32x16_bf16(PAF(1),VFR(1),o[0],0,0,0), C0,8); \
    KRD(GL,1); GAPB(o[1]=__builtin_amdgcn_mfma_f32_32x32x16_bf16(PAF(1),VFR(5),o[1],0,0,0), C0,12); \
    KRD(GL,2); GAPB(o[0]=__builtin_amdgcn_mfma_f32_32x32x16_bf16(PAF(2),VFR(2),o[0],0,0,0), C1,0); \
    KRD(GL,3); GAPB(o[1]=__builtin_amdgcn_mfma_f32_32x32x16_bf16(PAF(2),VFR(6),o[1],0,0,0), C1,4); \
    GAPB(o[0]=__builtin_amdgcn_mfma_f32_32x32x16_bf16(PAF(3),VFR(3),o[0],0,0,0), C1,8); \
    GAPB(o[1]=__builtin_amdgcn_mfma_f32_32x32x16_bf16(PAF(3),VFR(7),o[1],0,0,0), C1,12); \
    }while(0)
  int t=1;
  for(;t+5<NT;t+=2){
    STEP(pB0,pB1,pA0,pA1,t,true,true,true);     WAIT_BAR(2); RESC(); ROT();
    STEP(pA0,pA1,pB0,pB1,t+1,true,true,true);   WAIT_BAR(2); RESC(); ROT();
  }
  #define ENDW(tt) do{ if((tt)+3<NT){WAIT_BAR(2);} else if((tt)+2<NT){WAIT_BAR(1);} else {WAIT_BAR(0);} }while(0)
  for(;t+1<NT;t+=2){
    STEP(pB0,pB1,pA0,pA1,t,(t+3<NT),(t+1<NT),(t+1<NT));       ENDW(t);   RESC(); ROT();
    STEP(pA0,pA1,pB0,pB1,t+1,(t+4<NT),(t+2<NT),(t+2<NT));     ENDW(t+1); RESC(); ROT();
  }
  STEP(pB0,pB1,pA0,pA1,NT-1,false,false,false); RESC();
  { float sacc=pB0[0]+pB0[1]; _Pragma("unroll") for(int r=2;r<16;++r)sacc+=pB0[r]; _Pragma("unroll") for(int r=0;r<16;++r)sacc+=pB1[r]; l_reg+=sacc;
    pw0=(u32x4){PKW(pB0,0),PKW(pB0,2),PKW(pB0,4),PKW(pB0,6)};pw1=(u32x4){PKW(pB0,8),PKW(pB0,10),PKW(pB0,12),PKW(pB0,14)};pw2=(u32x4){PKW(pB1,0),PKW(pB1,2),PKW(pB1,4),PKW(pB1,6)};pw3=(u32x4){PKW(pB1,8),PKW(pB1,10),PKW(pB1,12),PKW(pB1,14)};
    SBAR(); pv(o,vb0+sl_cur,PAF(0),PAF(1),PAF(2),PAF(3)); }
  #undef PKW
  #undef PAF
  #undef VFR
  #undef PIN
  #undef MX3
  #undef GAPA
  #undef GAPB
  #undef EX
  #undef VRD
  #undef KRD
  #undef STEP
  #undef ENDW
  {auto rr=__builtin_amdgcn_permlane32_swap(__float_as_uint(l_reg),__float_as_uint(l_reg),false,false);l_reg=__uint_as_float(rr[0])+__uint_as_float(rr[1]);}
  if(hi==0)wsf[32+r32]=l_reg;asm volatile("s_waitcnt lgkmcnt(0)":::"memory");
  float rli[16];
  #pragma unroll
  for(int r=0;r<16;++r)rli[r]=__builtin_amdgcn_rcpf(wsf[32+crow(r,hi)]);
  bf16*Ow=O+(rowbase+q0+wid*QBLK)*DM+h*D;
  { bf16*stg=(bf16*)(shm+LDS_OST)+wid*2048;
    #pragma unroll
    for(int r=0;r<16;++r){const int orow=crow(r,hi);
      #pragma unroll
      for(int d0=0;d0<2;++d0)stg[orow*64+d0*32+r32]=__float2bfloat16(o[d0][r]*rli[r]);}
    asm volatile("s_waitcnt lgkmcnt(0)":::"memory");
    const bf16*Gw=GT+(rowbase+q0+wid*QBLK)*DM+h*D;
    u32x4 gv[4];
    #pragma unroll
    for(int i=0;i<4;++i){const int row=i*8+(lane>>3),ch=lane&7; gv[i]=*(const u32x4*)(Gw+(long)row*DM+ch*8);}
    #pragma unroll
    for(int i=0;i<4;++i){const int row=i*8+(lane>>3),ch=lane&7; u32x4 v=*(const u32x4*)(stg+row*64+ch*8);
      #pragma unroll
      for(int e=0;e<4;++e){ const float o0=__uint_as_float(v[e]<<16)*__uint_as_float(gv[i][e]<<16), o1=__uint_as_float(v[e]&0xffff0000u)*__uint_as_float(gv[i][e]&0xffff0000u); v[e]=cvtpk_s(o0,o1); }
      ATTN_STORE16(Ow+(long)row*DM+ch*8,v);} }
  asm volatile("s_waitcnt lgkmcnt(0)\n\ts_barrier":::"memory");
  #undef CINIT
  #undef CKLD
  #undef CSUB
  #undef PT
  #undef DMA_K
  #undef DMA_V
  #undef CMASK
  #undef START
  #undef RESC
  #undef ROT
}
constexpr int ATTN_LDS_BYTES=LDS_BYTES;
struct AttnTensors { const bf16* Q; const bf16* K; const bf16* V; bf16* O; const bf16* G; const float* C2; };
struct AttnUnit { int bh; int qb; };
struct StaticOrder {
  int vcu, G;
  __device__ __forceinline__ explicit StaticOrder(int grid,int block):vcu((grid%8==0)?(block%8)*(grid/8)+block/8:block),G(grid){}
  __device__ __forceinline__ bool next(int i,AttnUnit&u)const{ const int bh=vcu+(i>>3)*G; if(bh>=BATCH*NHEAD)return false; u.bh=bh; u.qb=7-(i&7); return true; }
  __device__ __forceinline__ void a_ready(const AttnUnit&)const{}
  __device__ __forceinline__ void done(const AttnUnit&)const{}
};
template<class Sched,int THRL=8> __device__ __forceinline__ void attn_phase(char*lds,const AttnTensors&T,const Sched&S,const int tid){
  AttnUnit u;
  for(int i=0;S.next(i,u);++i){ S.a_ready(u); attn_unit<THRL>(u.bh/NHEAD,u.bh%NHEAD,u.qb,T.Q,T.K,T.V,T.O,T.G,T.C2,(i&7)==0,lds,tid); S.done(u); }
}
#undef SBAR
#undef WAIT_BAR
}
constexpr int NWAVES = 8;
constexpr int BATCH = 16, SEQ = 2048, D = 1024, NH = 16, FF = 2816, FF2 = 2 * FF;
constexpr int M = BATCH * SEQ;
constexpr int NKV = 2304;
constexpr float RMS_EPS = 1e-6f;
static_assert(attn_body::BATCH == BATCH && attn_body::SEQ == SEQ && attn_body::DM == D, "attention body geometry");
constexpr size_t MiB = 1u << 20;
constexpr size_t WS_CTL = 0, CTL_ZERO_BYTES = 65536;
constexpr int CW_BAR = 4096;
constexpr size_t WS_WFI = 2 * MiB;
constexpr size_t WS_WFO = 46 * MiB;
constexpr size_t WS_WCI = 68 * MiB;
constexpr size_t WS_WCO = 74 * MiB;
constexpr size_t WS_WKV = 76 * MiB;
constexpr size_t WS_WQG = 81 * MiB;
constexpr size_t WS_WO = 85 * MiB;
constexpr size_t WS_FL = 88 * MiB;
constexpr size_t WS_C2 = 90 * MiB;
constexpr size_t WS_RS = 92 * MiB;
constexpr size_t WS_XH = 96 * MiB;
constexpr size_t WS_R = 160 * MiB;
constexpr size_t WS_K = 352 * MiB, WS_V = 416 * MiB, WS_END = 480 * MiB;
static_assert(WS_WFI + 4 * (size_t)FF2 * D * 2 <= WS_WFO && WS_WFO + 4 * (size_t)D * FF * 2 <= WS_WCI && WS_WKV + (size_t)NKV * D * 2 <= WS_WQG && WS_R + (size_t)M * FF * 2 <= WS_K, "d_ws map");
constexpr int RING_BYTES = 131072, LDS_BYTES = 147456;
static_assert(attn_body::ATTN_LDS_BYTES <= RING_BYTES && pg8::STAGE_BYTES <= RING_BYTES, "LDS map");

#define GAS __attribute__((address_space(1)))
#define LAS __attribute__((address_space(3)))
typedef unsigned short bf16;
typedef unsigned v4u __attribute__((ext_vector_type(4)));
typedef unsigned v2u __attribute__((ext_vector_type(2)));
typedef float f32x4 __attribute__((ext_vector_type(4)));
#define LDS_WAIT() asm volatile("s_waitcnt lgkmcnt(0)" ::: "memory")
__device__ __forceinline__ unsigned f2bf(float f) { unsigned u = __builtin_bit_cast(unsigned, f); return (u + 0x7fffu + ((u >> 16) & 1u)) >> 16; }
__device__ __forceinline__ unsigned pk2(float lo, float hi) { return f2bf(lo) | (f2bf(hi) << 16); }
__device__ __forceinline__ float bflo(unsigned w) { return __uint_as_float(w << 16); }
__device__ __forceinline__ float bfhi(unsigned w) { return __uint_as_float(w & 0xffff0000u); }

struct Frame { LAS unsigned char* lds; int tid, lane, wave, vcu, G; };

__device__ __forceinline__ float wave_sum(float v) {
#pragma unroll
    for (int o = 1; o < 64; o <<= 1) v += __shfl_xor(v, o);
    return v;
}
#define XB_TMO      128
#define XB_XCNT(j)  (256  + 64 * (j))
#define XB_XSUB(j)  (1280 + 64 * (j))
#define XB_XGEN(j)  (2304 + 64 * (j))
#define XB_TOP      3328
#define XB_TOPGEN   3392
#define XCD_BAR_WORDS 3456
#define XB_SPIN_CAP (1u << 18)

__device__ __forceinline__ unsigned xb_ld(unsigned* p)              { return __hip_atomic_load(p, __ATOMIC_RELAXED, __HIP_MEMORY_SCOPE_AGENT); }
__device__ __forceinline__ unsigned xb_add(unsigned* p, unsigned v) { return __hip_atomic_fetch_add(p, v, __ATOMIC_RELAXED, __HIP_MEMORY_SCOPE_AGENT); }
__device__ __forceinline__ unsigned xb_xcc_id() { return (unsigned)__builtin_amdgcn_s_getreg((3 << 11) | 20) & 0xFu; }
#define XB_SPIN(cond, bar) do { unsigned _sp = 0; while (cond) { __builtin_amdgcn_s_sleep(1); \
    if ((++_sp & 255u) == 0u) { if (xb_ld(&(bar)[XB_TMO])) break; if (_sp > XB_SPIN_CAP) { atomicAdd(&(bar)[XB_TMO], 1u); break; } } } } while (0)

struct XcdBarrier {
    unsigned* bar; unsigned x;
    volatile LAS unsigned* st;
};

__device__ __forceinline__ XcdBarrier xcd_barrier_post(unsigned* bar, volatile LAS unsigned* st) {
    XcdBarrier b; b.bar = bar; b.x = xb_xcc_id(); b.st = st;
    if (threadIdx.x == 0) (void)xb_add(&bar[XB_XCNT(b.x)], 1u);
    return b;
}
__device__ __forceinline__ void xcd_barrier_complete(unsigned* bar, unsigned x, unsigned& nloc, unsigned& nx) {
    const unsigned G = gridDim.x * gridDim.y * gridDim.z;
    unsigned sum, cnt, mine, sp = 0u;
    for (;;) {
        sum = 0u; cnt = 0u; mine = 0u;
#pragma unroll
        for (unsigned j = 0; j < 16; ++j) { const unsigned c = xb_ld(&bar[XB_XCNT(j)]); sum += c; cnt += (c > 0u) ? 1u : 0u; mine = (j == x) ? c : mine; }
        if (sum == G) break;
        __builtin_amdgcn_s_sleep(1);
        if ((++sp & 255u) == 0u) { if (xb_ld(&bar[XB_TMO])) break; if (sp > XB_SPIN_CAP) { atomicAdd(&bar[XB_TMO], 1u); break; } }
    }
    nloc = mine > 0u ? mine : 1u; nx = cnt > 0u ? cnt : 1u;
}

__device__ __forceinline__ void xcd_barrier(const XcdBarrier& b) {
    asm volatile("s_waitcnt vmcnt(0)" ::: "memory");
    __syncthreads();
    if (threadIdx.x == 0) {
        unsigned* bar = b.bar;
        __builtin_amdgcn_s_waitcnt(0);
        unsigned nloc = b.st[0], nx = b.st[1];
        if (nloc == 0u) { xcd_barrier_complete(bar, b.x, nloc, nx); b.st[0] = nloc; b.st[1] = nx; }
        const unsigned old = xb_add(&bar[XB_XSUB(b.x)], 1u);
        const unsigned gen = old / nloc;
        if (old + 1u == (gen + 1u) * nloc) {
            __builtin_amdgcn_fence(__ATOMIC_RELEASE, "agent");
            asm volatile("s_waitcnt vmcnt(0)" ::: "memory");
            const unsigned og = xb_add(&bar[XB_TOP], 1u);
            const unsigned tg = og / nx;
            if (og + 1u == (tg + 1u) * nx) xb_add(&bar[XB_TOPGEN], 1u);
            else XB_SPIN(xb_ld(&bar[XB_TOPGEN]) == tg, bar);
            __builtin_amdgcn_fence(__ATOMIC_ACQUIRE, "agent");
            xb_add(&bar[XB_XGEN(b.x)], 1u);
            asm volatile("s_waitcnt vmcnt(0)" ::: "memory");
        } else {
            XB_SPIN(xb_ld(&bar[XB_XGEN(b.x)]) == gen, bar);
            __builtin_amdgcn_fence(__ATOMIC_ACQUIRE, "agent");
            asm volatile("s_waitcnt vmcnt(0)" ::: "memory");
        }
    }
    __syncthreads();
}

enum { MAP_PLAIN = 0, MAP_SWIGLU = 1, MAP_CONV = 2 };
__device__ __forceinline__ int map_row(int mode, int n0) {
    if (mode == MAP_SWIGLU) { const int up = n0 >= FF ? 1 : 0, j = n0 - up * FF; return 256 * (j >> 7) + 128 * up + (j & 127); }
    if (mode == MAP_CONV) { if (n0 < D) return 2 * D + n0; const int hh = n0 >= 2 * D ? 1 : 0, j = n0 - D - hh * D; return 256 * (j >> 7) + 128 * hh + (j & 127); }
    return n0;
}
__device__ __forceinline__ void cvt_item(const float* W, int ldw, int K, int ncols, const float* gain, bf16* WT, int mode, LAS float* scr, int item, int lane) {
    const int nblk = ncols / 32, kb = item / nblk, nb = item % nblk, k0 = 64 * kb, n0 = 32 * nb;
#pragma unroll 8
    for (int i = 0; i < 32; ++i) { const int kk = 2 * i + (lane >> 5); scr[kk * 33 + (lane & 31)] = W[(size_t)(k0 + kk) * ldw + n0 + (lane & 31)]; }
    const int c = lane & 7, drow = map_row(mode, n0);
    f32x4 g0 = (f32x4){1.f, 1.f, 1.f, 1.f}, g1 = g0;
    if (gain) { g0 = *(const f32x4*)(gain + k0 + 8 * c); g1 = *(const f32x4*)(gain + k0 + 8 * c + 4); }
    LDS_WAIT(); asm volatile("" ::: "memory");
#pragma unroll
    for (int j = 0; j < 4; ++j) { const int n = (lane >> 3) + 8 * j; const LAS float* s = scr + (8 * c) * 33 + n;
        v4u o; o.x = pk2(s[0 * 33] * g0[0], s[1 * 33] * g0[1]); o.y = pk2(s[2 * 33] * g0[2], s[3 * 33] * g0[3]); o.z = pk2(s[4 * 33] * g1[0], s[5 * 33] * g1[1]); o.w = pk2(s[6 * 33] * g1[2], s[7 * 33] * g1[3]);
        *(GAS v4u*)(WT + (size_t)(drow + n) * K + k0 + 8 * c) = o; }
    LDS_WAIT(); asm volatile("" ::: "memory");
}
struct Ptrs {
    const float *x, *ffn1_pre_g, *ffn1_post_g, *ffn1_w_in, *ffn1_w_out, *mix_pre_g, *mix_post_g, *ffn2_pre_g, *ffn2_post_g, *ffn2_w_in, *ffn2_w_out,
                *conv_w_in, *conv_k, *conv_w_out, *kv_g, *kv_w, *forget_b, *attn_w_qg, *attn_w_o;
};
__device__ __forceinline__ void convert_weights(const Frame& F, const Ptrs& P, unsigned char* ws) {
    LAS float* scr = (LAS float*)(F.lds + F.wave * 16384);
    const int gw = F.vcu * NWAVES + F.wave, NGW = F.G * NWAVES;
    constexpr int I_FI = (D / 64) * (FF2 / 32), I_FO = (FF / 64) * (D / 32), I_CI = (D / 64) * (3 * D / 32), I_DD = (D / 64) * (D / 32), I_2D = (D / 64) * (2 * D / 32);
    constexpr int NITEMS = 4 * I_FI + 4 * I_FO + I_CI + I_DD + I_2D + I_2D + I_DD;
    for (int it = gw; it < NITEMS; it += NGW) {
        int r = it;
        if (r < 4 * I_FI) { const int i = r / I_FI, l = i >> 1, w2 = i & 1; r -= i * I_FI;
            cvt_item((w2 ? P.ffn2_w_in : P.ffn1_w_in) + (size_t)l * D * FF2, FF2, D, FF2, (w2 ? P.ffn2_pre_g : P.ffn1_pre_g) + l * D, (bf16*)(ws + WS_WFI) + (size_t)i * FF2 * D, MAP_SWIGLU, scr, r, F.lane); continue; }
        r -= 4 * I_FI;
        if (r < 4 * I_FO) { const int i = r / I_FO, l = i >> 1, w2 = i & 1; r -= i * I_FO;
            cvt_item((w2 ? P.ffn2_w_out : P.ffn1_w_out) + (size_t)l * FF * D, D, FF, D, nullptr, (bf16*)(ws + WS_WFO) + (size_t)i * D * FF, MAP_PLAIN, scr, r, F.lane); continue; }
        r -= 4 * I_FO;
        if (r < I_CI) { cvt_item(P.conv_w_in, 3 * D, D, 3 * D, P.mix_pre_g, (bf16*)(ws + WS_WCI), MAP_CONV, scr, r, F.lane); continue; } r -= I_CI;
        if (r < I_DD) { cvt_item(P.conv_w_out, D, D, D, nullptr, (bf16*)(ws + WS_WCO), MAP_PLAIN, scr, r, F.lane); continue; } r -= I_DD;
        if (r < I_2D) { cvt_item(P.kv_w, 2 * D + NH, D, 2 * D, P.kv_g, (bf16*)(ws + WS_WKV), MAP_PLAIN, scr, r, F.lane); continue; } r -= I_2D;
        if (r < I_2D) { cvt_item(P.attn_w_qg, 2 * D, D, 2 * D, P.mix_pre_g + D, (bf16*)(ws + WS_WQG), MAP_PLAIN, scr, r, F.lane); continue; } r -= I_2D;
        cvt_item(P.attn_w_o, D, D, D, nullptr, (bf16*)(ws + WS_WO), MAP_PLAIN, scr, r, F.lane);
    }
    bf16* wkv = (bf16*)(ws + WS_WKV);
    const int gt = F.vcu * (NWAVES * 64) + F.tid, NGT = F.G * NWAVES * 64;
    for (int e = gt; e < NH * D; e += NGT) { const int n = e / D, k = e % D; wkv[(size_t)(2 * D + n) * D + k] = (bf16)f2bf(P.kv_w[(size_t)k * (2 * D + NH) + 2 * D + n] * P.kv_g[k]); }
    unsigned* wz = (unsigned*)(wkv + (size_t)(2 * D + NH) * D);
    for (int e = gt; e < (NKV - 2 * D - NH) * D / 2; e += NGT) wz[e] = 0u;
}
__device__ __forceinline__ void thin_phase(const Frame& F, const float* xin, bf16* X, const bf16* hb, const float* gpost, float w, float* rs, float* outf, int flags) {
    constexpr int R = 4;
    const int gw = F.vcu * NWAVES + F.wave, NGW = F.G * NWAVES, lane = F.lane;
    const bool has_h = flags & 1, src32 = flags & 2, fin = flags & 4;
    f32x4 gp[4];
#pragma unroll
    for (int j = 0; j < 4; ++j) gp[j] = has_h ? *(const GAS f32x4*)(gpost + 4 * lane + 256 * j) * w : (f32x4){0.f, 0.f, 0.f, 0.f};
    for (long base = (long)gw * R; base < M; base += (long)NGW * R) {
        f32x4 xv[R][4]; v2u hv[R][4];
        if (src32) {
#pragma unroll
            for (int r = 0; r < R; ++r)
#pragma unroll
                for (int j = 0; j < 4; ++j) xv[r][j] = *(const GAS f32x4*)(xin + (size_t)(base + r) * D + 4 * lane + 256 * j);
        } else {
#pragma unroll
            for (int r = 0; r < R; ++r)
#pragma unroll
                for (int j = 0; j < 4; ++j) { const v2u t = *(const GAS v2u*)(X + (size_t)(base + r) * D + 4 * lane + 256 * j); xv[r][j] = (f32x4){bflo(t.x), bfhi(t.x), bflo(t.y), bfhi(t.y)}; }
        }
        if (has_h) {
#pragma unroll
            for (int r = 0; r < R; ++r)
#pragma unroll
                for (int j = 0; j < 4; ++j) hv[r][j] = *(const GAS v2u*)(hb + (size_t)(base + r) * D + 4 * lane + 256 * j);
        }
#pragma unroll
        for (int r = 0; r < R; ++r) {
            if (has_h) {
                f32x4 h[4]; float ss = 0.f;
#pragma unroll
                for (int j = 0; j < 4; ++j) { h[j] = (f32x4){bflo(hv[r][j].x), bfhi(hv[r][j].x), bflo(hv[r][j].y), bfhi(hv[r][j].y)}; ss += (h[j].x * h[j].x + h[j].y * h[j].y) + (h[j].z * h[j].z + h[j].w * h[j].w); }
                const float rh = 1.0f / sqrtf(wave_sum(ss) * (1.0f / D) + RMS_EPS);
#pragma unroll
                for (int j = 0; j < 4; ++j) xv[r][j] += h[j] * rh * gp[j];
            }
            if (fin) {
#pragma unroll
                for (int j = 0; j < 4; ++j) *(GAS f32x4*)(outf + (size_t)(base + r) * D + 4 * lane + 256 * j) = xv[r][j];
            } else {
                float s2 = 0.f;
#pragma unroll
                for (int j = 0; j < 4; ++j) s2 += (xv[r][j].x * xv[r][j].x + xv[r][j].y * xv[r][j].y) + (xv[r][j].z * xv[r][j].z + xv[r][j].w * xv[r][j].w);
                const float r2 = 1.0f / sqrtf(wave_sum(s2) * (1.0f / D) + RMS_EPS);
                if (lane == 0) rs[base + r] = r2;
#pragma unroll
                for (int j = 0; j < 4; ++j) { v2u o; o.x = pk2(xv[r][j].x, xv[r][j].y); o.y = pk2(xv[r][j].z, xv[r][j].w); *(GAS v2u*)(X + (size_t)(base + r) * D + 4 * lane + 256 * j) = o; }
            }
        }
    }
}
__device__ __forceinline__ void conv_phase(const Frame& F, const bf16* U, const bf16* Bg, const float* ck, bf16* Z) {
    constexpr int RB = 16;
    const int gw = F.vcu * NWAVES + F.wave, NGW = F.G * NWAVES, lane = F.lane;
    for (int it = gw; it < (M / RB) * 2; it += NGW) {
        const int r0 = (it >> 1) * RB, c0 = (it & 1) * 512 + lane * 8;
        float kw[3][8];
#pragma unroll
        for (int wq = 0; wq < 3; ++wq) { const f32x4 a = *(const f32x4*)(ck + wq * D + c0), b = *(const f32x4*)(ck + wq * D + c0 + 4);
            kw[wq][0] = a.x; kw[wq][1] = a.y; kw[wq][2] = a.z; kw[wq][3] = a.w; kw[wq][4] = b.x; kw[wq][5] = b.y; kw[wq][6] = b.z; kw[wq][7] = b.w; }
        const bool first = (r0 % SEQ) == 0;
        v4u u2 = (v4u){0u, 0u, 0u, 0u}, u1 = u2;
        if (!first) { u2 = *(const GAS v4u*)(U + (size_t)(r0 - 2) * D + c0); u1 = *(const GAS v4u*)(U + (size_t)(r0 - 1) * D + c0); }
#pragma unroll 4
        for (int r = 0; r < RB; ++r) {
            const v4u u0 = *(const GAS v4u*)(U + (size_t)(r0 + r) * D + c0), bg = *(const GAS v4u*)(Bg + (size_t)(r0 + r) * D + c0);
            v4u o;
#pragma unroll
            for (int e = 0; e < 4; ++e) {
                const float ylo = kw[0][2 * e] * bflo(u2[e]) + kw[1][2 * e] * bflo(u1[e]) + kw[2][2 * e] * bflo(u0[e]);
                const float yhi = kw[0][2 * e + 1] * bfhi(u2[e]) + kw[1][2 * e + 1] * bfhi(u1[e]) + kw[2][2 * e + 1] * bfhi(u0[e]);
                o[e] = pk2(ylo * bflo(bg[e]), yhi * bfhi(bg[e]));
            }
            *(GAS v4u*)(Z + (size_t)(r0 + r) * D + c0) = o;
            u2 = u1; u1 = u0;
        }
    }
}
__device__ __forceinline__ void cumsum_phase(const Frame& F, const float* FL, const float* fb, float* C2) {
    if (F.wave != 0) return;
    for (int bh = F.vcu; bh < BATCH * NH; bh += F.G) {
        const int b = bh / NH, h = bh % NH; const float bias = fb[h]; float carry = 0.f;
        for (int j = 0; j < SEQ / 64; ++j) {
            const int t = 64 * j + F.lane; const float xl = FL[((size_t)b * SEQ + t) * NH + h] + bias;
            float v = fminf(xl, 0.f) - log1pf(expf(-fabsf(xl)));
#pragma unroll
            for (int o = 1; o < 64; o <<= 1) { const float y = __shfl_up(v, o); if (F.lane >= o) v += y; }
            v += carry; C2[(size_t)bh * SEQ + t] = v * 1.4426950408889634f; carry = __shfl(v, 63);
        }
    }
}

#ifndef PROBE
#define PROBE 0
#endif
struct Args { const float* in[19]; float* out; unsigned char* ws; };
__global__ void __launch_bounds__(NWAVES * 64, 2) yoco_fwd(Args args) {
    extern __shared__ __attribute__((aligned(16))) unsigned char lds[];
    cg::grid_group grid = cg::this_grid();
    Frame F;
    F.lds = (LAS unsigned char*)lds; F.tid = threadIdx.x; F.lane = F.tid & 63; F.wave = __builtin_amdgcn_readfirstlane(F.tid >> 6);
    F.G = gridDim.x; { const int bx = blockIdx.x; F.vcu = (F.G % 8 == 0) ? (bx % 8) * (F.G / 8) + bx / 8 : bx; }
    volatile LAS unsigned* const MISC = (volatile LAS unsigned*)(F.lds + RING_BYTES + 512);
    if (F.tid < 32) MISC[F.tid] = 0u;
    __syncthreads();
    const XcdBarrier xbar = xcd_barrier_post((unsigned*)(args.ws + WS_CTL) + CW_BAR, MISC + 8);
    Ptrs P;
    P.x = args.in[0]; P.ffn1_pre_g = args.in[1]; P.ffn1_post_g = args.in[2]; P.ffn1_w_in = args.in[3]; P.ffn1_w_out = args.in[4]; P.mix_pre_g = args.in[5]; P.mix_post_g = args.in[6];
    P.ffn2_pre_g = args.in[7]; P.ffn2_post_g = args.in[8]; P.ffn2_w_in = args.in[9]; P.ffn2_w_out = args.in[10]; P.conv_w_in = args.in[11]; P.conv_k = args.in[12]; P.conv_w_out = args.in[13];
    P.kv_g = args.in[14]; P.kv_w = args.in[15]; P.forget_b = args.in[16]; P.attn_w_qg = args.in[17]; P.attn_w_o = args.in[18];
    float* out = args.out; unsigned char* ws = args.ws;
    bf16* const XH = (bf16*)(ws + WS_XH); bf16* const RH = (bf16*)(ws + WS_R);
    bf16* const Ub = RH; bf16* const Bgb = RH + (size_t)M * D; bf16* const Zb = RH + 2 * (size_t)M * D;
    bf16* const Qb = RH; bf16* const Gtb = RH + (size_t)M * D; bf16* const Ob = RH + 2 * (size_t)M * D;
    bf16* const Kb = (bf16*)(ws + WS_K); bf16* const Vb = (bf16*)(ws + WS_V);
    bf16* const WFI = (bf16*)(ws + WS_WFI); bf16* const WFO = (bf16*)(ws + WS_WFO);
    float* const FL = (float*)(ws + WS_FL); float* const C2 = (float*)(ws + WS_C2); float* const RS = (float*)(ws + WS_RS);
    bf16* const HS = (bf16*)out;

    enum { K_GEMM = 0, K_THIN = 1, K_CONV = 2, K_ATT = 3 };
    struct PhaseDesc { unsigned long long p0, p1, p2, p3; int kind, mode, N, K, ldc, flags; float w; int sync; };
    LAS unsigned* const tabw = (LAS unsigned*)(F.lds + RING_BYTES + 1024);
#define TAB_PUT(i, d) do { LAS unsigned* t_ = tabw + 16 * (i); t_[0] = (unsigned)(d).p0; t_[1] = (unsigned)((d).p0 >> 32); t_[2] = (unsigned)(d).p1; t_[3] = (unsigned)((d).p1 >> 32); t_[4] = (unsigned)(d).p2; t_[5] = (unsigned)((d).p2 >> 32); \
        t_[6] = (unsigned)(d).p3; t_[7] = (unsigned)((d).p3 >> 32); t_[8] = (unsigned)(d).kind; t_[9] = (unsigned)(d).mode; t_[10] = (unsigned)(d).N; t_[11] = (unsigned)(d).K; t_[12] = (unsigned)(d).ldc; t_[13] = (unsigned)(d).flags; \
        t_[14] = __float_as_uint((d).w); t_[15] = (unsigned)(d).sync; } while (0)
    if (F.tid == 0) {
        int n_ = 0;
#define PD_GEMM(i, A_, B_, N_, K_, mode_, O0_, O1_, ldc_, sync_) do { PhaseDesc d; d.p0 = (unsigned long long)(A_); d.p1 = (unsigned long long)(B_); d.p2 = (unsigned long long)(O0_); d.p3 = (unsigned long long)(O1_); \
        d.kind = K_GEMM; d.mode = (mode_); d.N = (N_); d.K = (K_); d.ldc = (ldc_); d.flags = 0; d.w = 0.f; d.sync = (sync_); TAB_PUT(n_, d); ++n_; if (PROBE == 1) { d.sync = 1; TAB_PUT(n_, d); ++n_; } } while (0)
#define PD_THIN(i, hs_, g_, w_, flags_, cums_, sync_) do { PhaseDesc d; d.p0 = (unsigned long long)(hs_); d.p1 = (unsigned long long)(g_); d.p2 = 0; d.p3 = 0; \
        d.kind = K_THIN; d.mode = (cums_); d.N = 0; d.K = 0; d.ldc = 0; d.flags = (flags_); d.w = (w_); d.sync = (sync_); TAB_PUT(n_, d); ++n_; } while (0)
#define PD_OTHER(i, kind_) do { PhaseDesc d; d.p0 = 0; d.p1 = 0; d.p2 = 0; d.p3 = 0; d.kind = (kind_); d.mode = 0; d.N = 0; d.K = 0; d.ldc = 0; d.flags = 0; d.w = 0.f; d.sync = 1; TAB_PUT(n_, d); ++n_; if (PROBE == 2 && (kind_) == K_ATT) { TAB_PUT(n_, d); ++n_; } } while (0)
#define PD_UP(i, j)   PD_GEMM(i, XH, WFI + (size_t)(j) * FF2 * D, FF2, D, pg8::EM_SWIGLU, RH, 0, FF, 1)
#define PD_DOWN(i, j, hs) PD_GEMM(i, RH, WFO + (size_t)(j) * D * FF, D, FF, pg8::EM_PLAIN, hs, 0, D, 1)
        PD_UP(0, 0); PD_DOWN(1, 0, HS);
        PD_THIN(2, HS, P.ffn1_post_g, 0.5f, 1, 0, 1);
        PD_GEMM(3, XH, ws + WS_WCI, 3 * D, D, pg8::EM_CONV, Ub, Bgb, D, 1);
        PD_OTHER(4, K_CONV);
        PD_GEMM(5, Zb, ws + WS_WCO, D, D, pg8::EM_PLAIN, HS, 0, D, 1);
        PD_THIN(6, HS, P.mix_post_g, 1.0f, 1, 0, 1);
        PD_UP(7, 1); PD_DOWN(8, 1, HS);
        PD_THIN(9, HS, P.ffn2_post_g, 0.5f, 1, 0, 1);
        PD_GEMM(10, XH, ws + WS_WKV, NKV, D, pg8::EM_KV, Kb, Vb, D, 0);
        PD_UP(11, 2); PD_DOWN(12, 2, HS);
        PD_THIN(13, HS, P.ffn1_post_g + D, 0.5f, 1, 1, 1);
        PD_GEMM(14, XH, ws + WS_WQG, 2 * D, D, pg8::EM_QG, Qb, Gtb, D, 1);
        PD_OTHER(15, K_ATT);
        PD_GEMM(16, Ob, ws + WS_WO, D, D, pg8::EM_PLAIN, HS, 0, D, 1);
        PD_THIN(17, HS, P.mix_post_g + D, 1.0f, 1, 0, 1);
        PD_UP(18, 3); PD_DOWN(19, 3, Kb);
        PD_THIN(20, Kb, P.ffn2_post_g + D, 0.5f, 5, 0, 0);
        tabw[16 * 63] = (unsigned)n_;
#undef PD_GEMM
#undef PD_THIN
#undef PD_OTHER
#undef PD_UP
#undef PD_DOWN
    }
    convert_weights(F, P, ws);
#if PROBE == 3
    convert_weights(F, P, ws);
#endif
    thin_phase(F, P.x, XH, nullptr, nullptr, 0.f, RS, nullptr, 2);
    const float* const conv_k = P.conv_k; const float* const forget_b = P.forget_b;
    grid.sync();
#define RFL(v) __builtin_amdgcn_readfirstlane((int)(v))
#define RFL64(v) (((unsigned long long)(unsigned)RFL((v) >> 32) << 32) | (unsigned long long)(unsigned)RFL((v) & 0xffffffffull))
    const int wave0 = F.wave, bx0 = (int)blockIdx.x, vcu0 = F.vcu;
    const int NPH = RFL(tabw[16 * 63]);
    for (int ph = 0; ph < NPH; ++ph) {
        int tid, bx = bx0, vcu = vcu0; asm volatile("v_mbcnt_lo_u32_b32 %0, -1, 0\n\tv_mbcnt_hi_u32_b32 %0, -1, %0" : "=v"(tid)); asm volatile("" : "+s"(bx), "+s"(vcu));
        tid += wave0 * 64;
        F.tid = tid; F.lane = tid & 63; F.wave = __builtin_amdgcn_readfirstlane(tid >> 6); F.vcu = vcu;
        const LAS unsigned* const td = tabw + 16 * ph;
#define TD32(k) RFL(td[k])
#define TD64(k) (((unsigned long long)(unsigned)TD32((k) + 1) << 32) | (unsigned long long)(unsigned)TD32(k))
        const int kind = TD32(8);
        if (kind == K_GEMM) {
            pg8::Gemm g{(const bf16*)TD64(0), (const bf16*)TD64(2), M, TD32(10), TD32(11)};
            pg8::EpiMulti E{TD32(9), (pg8::EpiMulti::gbf)TD64(4), (pg8::EpiMulti::gbf)TD64(6), (pg8::EpiMulti::gf32)FL, TD32(12), attn_body::C2, (const GAS float*)RS};
            pg8::StaticOrder S; S.init(g.M, g.N, F.G, bx);
            pg8::gemm_phase<pg8::EpiMulti, pg8::StaticOrder, true, true>(F.lds, g, S, E, tid);
        } else if (kind == K_THIN) {
            if (TD32(9)) cumsum_phase(F, FL, forget_b, C2);
            thin_phase(F, nullptr, XH, (const bf16*)TD64(0), (const float*)TD64(2), __uint_as_float((unsigned)TD32(14)), RS, out, TD32(13));
        } else if (kind == K_CONV) {
            conv_phase(F, Ub, Bgb, conv_k, Zb);
        } else {
            const attn_body::AttnTensors AT{(const attn_body::bf16*)Qb, (const attn_body::bf16*)Kb, (const attn_body::bf16*)Vb, (attn_body::bf16*)Ob, (const attn_body::bf16*)Gtb, C2};
            const attn_body::StaticOrder S((int)F.G, bx);
            attn_body::attn_phase<attn_body::StaticOrder>((char*)lds, AT, S, tid);
        }
        asm volatile("" ::: "memory");
        if (TD32(15)) xcd_barrier(xbar);
#if PROBE == 4
        if (TD32(15)) xcd_barrier(xbar);
#endif
    }
#undef TD32
#undef TD64
#undef RFL
#undef RFL64
}

extern "C" void kernel_launch(void* const* d_in, const int* in_sizes, int n_in, void* d_out, int out_size, void* d_ws, size_t ws_size, hipStream_t stream) {
    static int grid = 0;
    if (grid == 0) {
        if (n_in != 19 || in_sizes[0] != M * D || out_size != M * D || ws_size < WS_END) { fprintf(stderr, "kernel_launch: unexpected shapes (n_in %d, in0 %d, out %d, ws %zu); nothing launched\n", n_in, n_in > 0 ? in_sizes[0] : -1, out_size, ws_size); grid = -1; return; }
        int dev = 0, cus = 0, per_cu = 0;
        if (hipGetDevice(&dev) != hipSuccess || hipDeviceGetAttribute(&cus, hipDeviceAttributeMultiprocessorCount, dev) != hipSuccess) { fprintf(stderr, "kernel_launch: device query failed\n"); grid = -1; return; }
        if (hipFuncSetAttribute((const void*)yoco_fwd, hipFuncAttributeMaxDynamicSharedMemorySize, LDS_BYTES) != hipSuccess) { fprintf(stderr, "kernel_launch: hipFuncSetAttribute failed\n"); grid = -1; return; }
        if (hipOccupancyMaxActiveBlocksPerMultiprocessor(&per_cu, (const void*)yoco_fwd, NWAVES * 64, LDS_BYTES) != hipSuccess || per_cu < 1) { fprintf(stderr, "kernel_launch: occupancy query says %d blocks per CU\n", per_cu); per_cu = 1; }
        (void)hipGetLastError();
        grid = cus * per_cu;
    }
    if (grid < 0) return;
    if (hipMemsetAsync((char*)d_ws + WS_CTL, 0, CTL_ZERO_BYTES, stream) != hipSuccess) { fprintf(stderr, "kernel_launch: hipMemsetAsync of the control words failed; nothing launched\n"); return; }
    Args a{};
    for (int i = 0; i < 19; ++i) a.in[i] = (const float*)d_in[i];
    a.out = (float*)d_out; a.ws = (unsigned char*)d_ws;
    void* kargs[] = {&a};
    const hipError_t e = hipLaunchCooperativeKernel((const void*)yoco_fwd, dim3(grid), dim3(NWAVES * 64), kargs, LDS_BYTES, stream);
    if (e != hipSuccess) fprintf(stderr, "kernel_launch: cooperative launch failed: %s (grid %d)\n", hipGetErrorString(e), grid);
}
```
